# Optimizing an MI355X kernel written in HIP

```python
import jax, jax.numpy as jnp
from jax import lax
import numpy as np

D_MODEL = 1024
BATCH = 16
SEQ = 4096
DEPTH = 2
DEC_BATCH = 32
DEC_SEQ = 64
PAST_LEN = 2048

CHUNK = 64
D_MIX = D_MODEL
ATTN_WIDTH = D_MIX // 2
CONV_CH = D_MIX - ATTN_WIDTH
HEAD_DIM = 64
N_HEADS = ATTN_WIDTH // HEAD_DIM
KV_HEADS = 2
GROUP = N_HEADS // KV_HEADS
WINDOW = 128
W_CHUNKS = WINDOW // CHUNK
CONV_WIDTH = 31
D_FF = 4 * D_MODEL
EPS = 1e-5
Q_DIM = N_HEADS * HEAD_DIM
KV_DIM = KV_HEADS * HEAD_DIM
IN_DIM = Q_DIM + 2 * KV_DIM + 2 * CONV_CH
SPLITS = (Q_DIM, Q_DIM + KV_DIM, Q_DIM + 2 * KV_DIM, Q_DIM + 2 * KV_DIM + CONV_CH)
NEG_INF = -1e30

kernel_name = "hymba_swa_sink_conformer_conv_stream_step"


def _rmsnorm(x, g):
    xf = x.astype(jnp.float32)
    y = xf * lax.rsqrt(jnp.mean(xf * xf, axis=-1, keepdims=True) + EPS)
    return (y * g.astype(jnp.float32)).astype(x.dtype)


def _layernorm(x, g, b):
    xf = x.astype(jnp.float32)
    mu = jnp.mean(xf, axis=-1, keepdims=True)
    xc = xf - mu
    var = jnp.mean(xc * xc, axis=-1, keepdims=True)
    y = xc * lax.rsqrt(var + EPS) * g.astype(jnp.float32) + b.astype(jnp.float32)
    return y.astype(x.dtype)


def _sink_softmax(s, sink):
    sk = sink.astype(jnp.float32)[:, :, None, None]
    m = jnp.maximum(jnp.max(s, axis=-1, keepdims=True), sk)
    p = jnp.exp(s - m)
    return p / (jnp.sum(p, axis=-1, keepdims=True) + jnp.exp(sk - m))


def _swa_prompt(q, k, v, sink):
    B, S = q.shape[:2]
    nc = S // CHUNK
    band = (W_CHUNKS + 1) * CHUNK
    qb = (q * (HEAD_DIM ** -0.5)).reshape(B, nc, CHUNK, KV_HEADS, GROUP, HEAD_DIM)
    pad = ((0, 0), (W_CHUNKS * CHUNK, 0), (0, 0), (0, 0))
    kc = jnp.pad(k, pad).reshape(B, nc + W_CHUNKS, CHUNK, KV_HEADS, HEAD_DIM)
    vc = jnp.pad(v, pad).reshape(B, nc + W_CHUNKS, CHUNK, KV_HEADS, HEAD_DIM)
    kb = jnp.concatenate([kc[:, j:j + nc] for j in range(W_CHUNKS + 1)], axis=2)
    vb = jnp.concatenate([vc[:, j:j + nc] for j in range(W_CHUNKS + 1)], axis=2)
    s = jnp.einsum('bcqkgd,bcjkd->bckgqj', qb, kb).astype(jnp.float32)
    key_chunk = jnp.arange(nc)[:, None] - W_CHUNKS + jnp.arange(band)[None, :] // CHUNK
    valid = key_chunk >= 0
    s = jnp.where(valid[None, :, None, None, None, :], s, NEG_INF)
    p = _sink_softmax(s, sink).astype(v.dtype)
    o = jnp.einsum('bckgqj,bcjkd->bcqkgd', p, vb).reshape(B, S, Q_DIM)
    keep = min(WINDOW, S)
    return o, k[:, S - keep:], v[:, S - keep:]


def _swa_sample(q, k, v, sink, cache_k, cache_v):
    B, T = q.shape[:2]
    kk = jnp.concatenate([cache_k, k], axis=1)
    vv = jnp.concatenate([cache_v, v], axis=1)
    qg = (q * (HEAD_DIM ** -0.5)).reshape(B, T, KV_HEADS, GROUP, HEAD_DIM)
    s = jnp.einsum('btkgd,bjkd->bkgtj', qg, kk).astype(jnp.float32)
    p = _sink_softmax(s, sink).astype(v.dtype)
    o = jnp.einsum('bkgtj,bjkd->btkgd', p, vv).reshape(B, T, Q_DIM)
    keep = cache_k.shape[1]
    return o, kk[:, -keep:], vv[:, -keep:]


def _conv_module(a, g, hist, conv_w, conv_b, ln_g, ln_b):
    u = a * jax.nn.sigmoid(g)
    full = jnp.concatenate([hist, u], axis=1)
    h = lax.conv_general_dilated(full, conv_w[:, None, :], window_strides=(1,), padding='VALID',
                                 dimension_numbers=('NWC', 'WIO', 'NWC'),
                                 feature_group_count=CONV_CH) + conv_b
    h = jax.nn.silu(_layernorm(h, ln_g, ln_b))
    return h, full[:, -(CONV_WIDTH - 1):]


def _layer(x, cache_k, cache_v, conv_hist, norm1, w_in, sink, conv_w, conv_b, ln_g, ln_b,
           w_out, norm2, w_up, w_down):
    B, T, _ = x.shape
    xn = _rmsnorm(x, norm1)
    proj = xn @ w_in
    q, k, v, a, g = jnp.split(proj, SPLITS, axis=-1)
    q = q.reshape(B, T, N_HEADS, HEAD_DIM)
    k = k.reshape(B, T, KV_HEADS, HEAD_DIM)
    v = v.reshape(B, T, KV_HEADS, HEAD_DIM)
    sink_g = sink.reshape(KV_HEADS, GROUP)
    if cache_k is None:
        o_attn, k_new, v_new = _swa_prompt(q, k, v, sink_g)
    else:
        o_attn, k_new, v_new = _swa_sample(q, k, v, sink_g, cache_k, cache_v)
    o_conv, conv_new = _conv_module(a, g, conv_hist, conv_w, conv_b, ln_g, ln_b)
    x = x + jnp.concatenate([o_attn, o_conv], axis=-1) @ w_out
    hn = _rmsnorm(x, norm2)
    x = x + jnp.square(jax.nn.relu(hn @ w_up)) @ w_down
    return x, k_new, v_new, conv_new


def setup_inputs(seed: int = 0) -> dict:
    key = jax.random.key(seed)
    ks = jax.random.split(key, 20)
    f32 = jnp.float32
    win = min(WINDOW, PAST_LEN)
    n = jax.random.normal
    return {
        "x_prompt": n(ks[0], (BATCH, SEQ, D_MODEL), f32),
        "x_sample": n(ks[1], (DEC_BATCH, DEC_SEQ, D_MODEL), f32),
        "cache_k": n(ks[2], (DEPTH, DEC_BATCH, win, KV_HEADS, HEAD_DIM), f32),
        "cache_v": n(ks[3], (DEPTH, DEC_BATCH, win, KV_HEADS, HEAD_DIM), f32),
        "state_conv": 0.5 * n(ks[4], (DEPTH, DEC_BATCH, CONV_WIDTH - 1, CONV_CH), f32),
        "norm1": 1.0 + 0.05 * n(ks[5], (DEPTH, D_MODEL), f32),
        "w_in": n(ks[6], (DEPTH, D_MODEL, IN_DIM), f32) * D_MODEL ** -0.5,
        "attn_sink": 0.5 * n(ks[7], (DEPTH, N_HEADS), f32),
        "conv_w": n(ks[8], (DEPTH, CONV_WIDTH, CONV_CH), f32) * CONV_WIDTH ** -0.5,
        "conv_b": 0.01 * n(ks[9], (DEPTH, CONV_CH), f32),
        "conv_ln_g": 1.0 + 0.05 * n(ks[10], (DEPTH, CONV_CH), f32),
        "conv_ln_b": 0.01 * n(ks[11], (DEPTH, CONV_CH), f32),
        "w_out": n(ks[12], (DEPTH, D_MIX, D_MODEL), f32) * D_MIX ** -0.5,
        "norm2": 1.0 + 0.05 * n(ks[13], (DEPTH, D_MODEL), f32),
        "w_up": n(ks[14], (DEPTH, D_MODEL, D_FF), f32) * D_MODEL ** -0.5,
        "w_down": n(ks[15], (DEPTH, D_FF, D_MODEL), f32) * D_FF ** -0.5,
        "final_norm": 1.0 + 0.05 * n(ks[16], (D_MODEL,), f32),
    }


def reference(x_prompt, x_sample, cache_k, cache_v, state_conv, norm1, w_in, attn_sink, conv_w,
              conv_b, conv_ln_g, conv_ln_b, w_out, norm2, w_up, w_down, final_norm):
    yp, ys = x_prompt, x_sample
    kp_l, vp_l, cp_l, ks_l, vs_l, cs_l = [], [], [], [], [], []
    for l in range(DEPTH):
        params = (norm1[l], w_in[l], attn_sink[l], conv_w[l], conv_b[l], conv_ln_g[l],
                  conv_ln_b[l], w_out[l], norm2[l], w_up[l], w_down[l])
        hist0 = jnp.zeros((yp.shape[0], CONV_WIDTH - 1, CONV_CH), yp.dtype)
        yp, kp, vp, cp = _layer(yp, None, None, hist0, *params)
        ys, k_s, v_s, c_s = _layer(ys, cache_k[l], cache_v[l], state_conv[l], *params)
        kp_l.append(kp); vp_l.append(vp); cp_l.append(cp)
        ks_l.append(k_s); vs_l.append(v_s); cs_l.append(c_s)
    y_prompt = _rmsnorm(yp, final_norm)
    y_sample = _rmsnorm(ys, final_norm)
    new_k_prompt = jnp.stack(kp_l)
    new_v_prompt = jnp.stack(vp_l)
    new_conv_prompt = jnp.stack(cp_l)
    new_k_sample = jnp.stack(ks_l)
    new_v_sample = jnp.stack(vs_l)
    new_conv_sample = jnp.stack(cs_l)
    return (y_prompt, y_sample, new_k_prompt, new_v_prompt, new_conv_prompt,
            new_k_sample, new_v_sample, new_conv_sample)
```

```cpp
#include <hip/hip_runtime.h>
#include <hip/hip_cooperative_groups.h>
#include <cstdio>
#include <cstdint>
namespace cg = cooperative_groups;
namespace pg8 {
#define PG8_LAS __attribute__((address_space(3)))
typedef unsigned short bf16_t;
typedef short bf16x8 __attribute__((ext_vector_type(8)));
typedef float f32x4 __attribute__((ext_vector_type(4)));
typedef unsigned u32x4 __attribute__((ext_vector_type(4)));
constexpr int BM = 256, BK = 64, HALF = 128, HTB = HALF * BK * 2  , STAGE_BYTES = 8 * HTB, NXCD = 8, WGM = 8;

__host__ __device__ __forceinline__ int lds_byte(int r, int c) { const int st = (r >> 4) * 2 + (c >> 5), rr = r & 15, cc = c & 31, ob = rr * 64 + cc * 2; return st * 1024 + (ob ^ (((ob >> 9) & 1) << 5)); }
__host__ __device__ __forceinline__ void stage_rc(int b, int& R, int& C) { const int st = b / 1024, sb = b % 1024, swz = sb ^ (((sb >> 9) & 1) << 5); R = (st >> 1) * 16 + swz / 64; C = (st & 1) * 32 + (swz % 64) / 2; }
__host__ __device__ __forceinline__ int perm32(int rho) { const int n = rho >> 4, i = rho & 15; return 8 * (i >> 2) + 4 * n + (i & 3); }

struct Unit { int pm, pn, kz; };
struct Gemm { const bf16_t* A; const bf16_t* Bt; int M, N, K, KL, ablk; };

struct StaticOrder {
    int nM, nN, nwg, G, c;
    __host__ __device__ void init(int M, int N, int G_, int c_) { nM = M / BM; nN = N / BM; nwg = nM * nN; G = G_; c = c_; }
    __host__ __device__ bool next(int i, Unit& u) const {
        const long L = (long)i * G + c; if (L >= nwg) return false;
        int wgid = (int)L; { const int q = nwg / NXCD, r = nwg % NXCD, xcd = wgid % NXCD, off = wgid / NXCD; wgid = (xcd < r ? xcd * (q + 1) : r * (q + 1) + (xcd - r) * q) + off; }
        const int wgm = nN >= 7 ? 4 : WGM;
        const int nig = wgm * nN, gid = wgid / nig, fm = gid * wgm, gsz = (nM - fm) < wgm ? (nM - fm) : wgm;
        u.pm = fm + ((wgid % nig) % gsz); u.pn = (wgid % nig) / gsz; u.kz = 0; return true;
    }
    int mode;
    __host__ __device__ bool next_any(int i, Unit& u) const {
        if (mode == 0) return next(i, u);
        const int p = i * G + c; if (p >= 256) return false;
        u.kz = p & 7; const int t = p >> 3; u.pm = 256 + (t >> 2); u.pn = t & 3; return true;
    }
    __device__ __forceinline__ void a_ready(const Unit&) const {}
    __device__ __forceinline__ void done(const Unit&) const {}
};

__device__ __forceinline__ unsigned cvt_pk_bf16(float lo, float hi) { unsigned r; asm volatile("v_cvt_pk_bf16_f32 %0, %1, %2" : "=v"(r) : "v"(lo), "v"(hi)); return r; }
template <class Epi, class Sched, bool ALIGN_EPI = false, bool SP2 = false>
__device__ __forceinline__ void gemm_phase(PG8_LAS unsigned char* lds, const Gemm g, const Sched& S, const Epi& E, const int tid_in) {
    const int tid = tid_in, wid = __builtin_amdgcn_readfirstlane(tid >> 6), lane = tid & 63, wr = wid >> 2, wc = wid & 3, fr = lane & 15, fq = lane >> 4;
    const int K = g.K, nt = g.KL / BK;
    const int pitchA = g.ablk ? BK : K;
    unsigned voffA[2], voffB[2];
#pragma unroll
    for (int i = 0; i < 2; ++i) { int R, C; stage_rc(tid * 16 + i * 8192, R, C); const int Rb = Epi::PERM ? ((R >> 5) * 64 + perm32(R & 31)) : R;
        voffA[i] = (unsigned)(R * pitchA + C) * 2u; voffB[i] = (unsigned)(Rb * K + C) * 2u; }
    const size_t kstep = (size_t)(BK * 2);
    const size_t hstep = (size_t)HALF * K * 2;
    const size_t tstep = 2 * hstep;
    const size_t hstepB = Epi::PERM ? (size_t)32 * K * 2 : hstep;
    const size_t kstepA = g.ablk ? (size_t)(BM * BK * 2) : kstep, hstepA = g.ablk ? (size_t)(HALF * BK * 2) : hstep, tstepA = g.ablk ? (size_t)(K / BK) * (size_t)(BM * BK * 2) : tstep;
    const unsigned ldsw = (unsigned)wid * 1024u;
    const int aoff = lds_byte(wr * 64 + fr, fq * 8), boff = lds_byte(wc * 32 + fr, fq * 8);
#define PG8_SA(b, h) (((b) * 2 + (h)) * HTB)
#define PG8_SB(b, h) ((4 + (b) * 2 + (h)) * HTB)
#define PG8_STAGE(bufoff, gbase, voff) do { _Pragma("unroll") for (int _i = 0; _i < 2; ++_i) \
        __builtin_amdgcn_global_load_lds((const unsigned*)((const char*)(gbase) + (voff)[_i]), (PG8_LAS unsigned*)(lds + (bufoff) + ldsw + _i * 8192), 16, 0, 0); } while (0)
#define PG8_LDA(dst, b, h) do { _Pragma("unroll") for (int m = 0; m < 4; ++m) _Pragma("unroll") for (int k = 0; k < 2; ++k) dst[m][k] = *(const PG8_LAS bf16x8*)(lds + PG8_SA(b, h) + aoff + m * 2048 + k * 1024); } while (0)
#define PG8_LDB(dst, b, h) do { _Pragma("unroll") for (int n = 0; n < 2; ++n) _Pragma("unroll") for (int k = 0; k < 2; ++k) dst[n][k] = *(const PG8_LAS bf16x8*)(lds + PG8_SB(b, h) + boff + n * 2048 + k * 1024); } while (0)
#define PG8_MMA(ai, bj, At, Bt) do { __builtin_amdgcn_s_setprio(1); _Pragma("unroll") for (int m = 0; m < 4; ++m) _Pragma("unroll") for (int n = 0; n < 2; ++n) _Pragma("unroll") for (int k = 0; k < 2; ++k) \
        acc[ai][bj][m][n] = __builtin_amdgcn_mfma_f32_16x16x32_bf16(Bt[n][k], At[m][k], acc[ai][bj][m][n], 0, 0, 0); __builtin_amdgcn_s_setprio(0); } while (0)
#define PG8_WAIT_V(n) asm volatile("s_waitcnt vmcnt(" #n ")" ::: "memory")
#define PG8_WAIT_L(n) asm volatile("s_waitcnt lgkmcnt(" #n ")" ::: "memory")
#define PG8_BAR __builtin_amdgcn_s_barrier()
#define PG8_SCHED __builtin_amdgcn_sched_barrier(0)
    Unit cur, nxt; int ui = 0;
    if (!S.next_any(0, cur)) return;
    f32x4 acc[2][2][4][2];
#pragma unroll
    for (int a = 0; a < 2; ++a)
#pragma unroll
        for (int b = 0; b < 2; ++b)
#pragma unroll
            for (int m = 0; m < 4; ++m)
#pragma unroll
                for (int n = 0; n < 2; ++n) acc[a][b][m][n] = (f32x4){0.f, 0.f, 0.f, 0.f};
    bf16x8 At[4][2], B0[2][2], B1[2][2];
    const char* cA = (const char*)g.A + (size_t)cur.pm * tstepA + (size_t)cur.kz * nt * kstepA; const char* cB = (const char*)g.Bt + (size_t)cur.pn * tstep + (size_t)cur.kz * g.KL * 2;
    S.a_ready(cur);
    if constexpr (SP2) {
        PG8_STAGE(PG8_SB(0, 0), cB, voffB); PG8_STAGE(PG8_SB(0, 1), cB + hstepB, voffB); PG8_STAGE(PG8_SA(0, 0), cA, voffA); PG8_STAGE(PG8_SA(0, 1), cA + hstepA, voffA);
        if (wr == 1) PG8_BAR;
        PG8_WAIT_V(2); PG8_BAR;
        PG8_STAGE(PG8_SB(1, 0), cB + kstep, voffB); PG8_STAGE(PG8_SA(1, 0), cA + kstepA, voffA); PG8_STAGE(PG8_SB(1, 1), cB + hstepB + kstep, voffB);
        PG8_WAIT_V(6); PG8_BAR;
    } else {
        PG8_STAGE(PG8_SB(0, 0), cB, voffB); PG8_STAGE(PG8_SA(0, 0), cA, voffA); PG8_STAGE(PG8_SB(0, 1), cB + hstepB, voffB); PG8_STAGE(PG8_SA(0, 1), cA + hstepA, voffA);
        if (wr == 1) PG8_BAR;
        PG8_WAIT_V(4); PG8_BAR;
        PG8_STAGE(PG8_SB(1, 0), cB + kstep, voffB); PG8_STAGE(PG8_SA(1, 0), cA + kstepA, voffA); PG8_STAGE(PG8_SB(1, 1), cB + hstepB + kstep, voffB);
        PG8_WAIT_V(6); PG8_BAR;
    }
    for (;;) {
        const bool has_next = S.next_any(ui + 1, nxt);
        const char* nA = has_next ? (const char*)g.A + (size_t)nxt.pm * tstepA + (size_t)nxt.kz * nt * kstepA : cA; const char* nB = has_next ? (const char*)g.Bt + (size_t)nxt.pn * tstep + (size_t)nxt.kz * g.KL * 2 : cB;
        for (int t = 0; t < nt; t += 2) {
            const bool last = (t == nt - 2);
            const char* a1 = cA + (size_t)(t + 1) * kstepA;
            const char* a2 = last ? nA : cA + (size_t)(t + 2) * kstepA; const char* b2 = last ? nB : cB + (size_t)(t + 2) * kstep;
            const char* a3 = a2 + kstepA; const char* b3 = b2 + kstep;
            if (last && has_next) S.a_ready(nxt);
            if constexpr (SP2) {
            PG8_LDB(B0, 0, 0); PG8_LDB(B1, 0, 1); PG8_SCHED; PG8_LDA(At, 0, 0); PG8_STAGE(PG8_SA(1, 1), a1 + hstepA, voffA);
            PG8_WAIT_V(8); PG8_WAIT_L(0); PG8_BAR; PG8_MMA(0, 0, At, B0); PG8_MMA(0, 1, At, B1); PG8_BAR; PG8_SCHED;
            PG8_LDA(At, 0, 1); PG8_STAGE(PG8_SB(0, 0), b2, voffB); PG8_STAGE(PG8_SB(0, 1), b2 + hstepB, voffB); PG8_STAGE(PG8_SA(0, 0), a2, voffA);
            PG8_WAIT_V(8); PG8_WAIT_L(0); PG8_BAR; PG8_MMA(1, 0, At, B0); PG8_MMA(1, 1, At, B1); PG8_BAR; PG8_SCHED;
            PG8_LDB(B0, 1, 0); PG8_LDB(B1, 1, 1); PG8_SCHED; PG8_LDA(At, 1, 0); PG8_STAGE(PG8_SA(0, 1), a2 + hstepA, voffA);
            PG8_WAIT_V(8); PG8_WAIT_L(0); PG8_BAR; PG8_MMA(0, 0, At, B0); PG8_MMA(0, 1, At, B1); PG8_BAR; PG8_SCHED;
            PG8_LDA(At, 1, 1); PG8_STAGE(PG8_SB(1, 0), b3, voffB); PG8_STAGE(PG8_SB(1, 1), b3 + hstepB, voffB); PG8_STAGE(PG8_SA(1, 0), a3, voffA);
            PG8_WAIT_V(8); PG8_WAIT_L(0); PG8_BAR; PG8_MMA(1, 0, At, B0); PG8_MMA(1, 1, At, B1); PG8_BAR; PG8_SCHED;
            } else {
            PG8_LDB(B0, 0, 0); PG8_SCHED; PG8_LDA(At, 0, 0); PG8_STAGE(PG8_SA(1, 1), a1 + hstepA, voffA);
            PG8_WAIT_L(8); PG8_BAR; PG8_WAIT_L(0); PG8_MMA(0, 0, At, B0); PG8_BAR; PG8_SCHED;
            PG8_LDB(B1, 0, 1); PG8_STAGE(PG8_SB(0, 0), b2, voffB);
            PG8_BAR; PG8_WAIT_L(0); PG8_MMA(0, 1, At, B1); PG8_BAR;
            PG8_LDA(At, 0, 1); PG8_STAGE(PG8_SA(0, 0), a2, voffA);
            PG8_BAR; PG8_WAIT_L(0); PG8_MMA(1, 0, At, B0); PG8_BAR; PG8_SCHED;
            PG8_STAGE(PG8_SB(0, 1), b2 + hstepB, voffB);
            PG8_WAIT_V(6); PG8_BAR; PG8_MMA(1, 1, At, B1); PG8_BAR;
            PG8_LDB(B0, 1, 0); PG8_SCHED; PG8_LDA(At, 1, 0); PG8_STAGE(PG8_SA(0, 1), a2 + hstepA, voffA);
            PG8_WAIT_L(8); PG8_BAR; PG8_WAIT_L(0); PG8_MMA(0, 0, At, B0); PG8_BAR; PG8_SCHED;
            PG8_LDB(B1, 1, 1); PG8_STAGE(PG8_SB(1, 0), b3, voffB);
            PG8_BAR; PG8_WAIT_L(0); PG8_MMA(0, 1, At, B1); PG8_BAR;
            PG8_LDA(At, 1, 1); PG8_STAGE(PG8_SA(1, 0), a3, voffA);
            PG8_BAR; PG8_WAIT_L(0); PG8_MMA(1, 0, At, B0); PG8_BAR; PG8_SCHED;
            PG8_STAGE(PG8_SB(1, 1), b3 + hstepB, voffB);
            PG8_WAIT_V(6); PG8_BAR; PG8_MMA(1, 1, At, B1); PG8_BAR;
            }
        }
        if constexpr (ALIGN_EPI) { if (wr == 0) PG8_BAR; }
        if constexpr (!Epi::AFTER_DRAIN) { E(acc, cur, wr, wc, fr, fq); S.done(cur); }
        if (!has_next) break;
#pragma unroll
        for (int a = 0; a < 2; ++a)
#pragma unroll
            for (int b = 0; b < 2; ++b)
#pragma unroll
                for (int m = 0; m < 4; ++m)
#pragma unroll
                    for (int n = 0; n < 2; ++n) acc[a][b][m][n] = (f32x4){0.f, 0.f, 0.f, 0.f};
        cur = nxt; cA = nA; cB = nB; ++ui;
        if constexpr (ALIGN_EPI) { if (wr == 1) PG8_BAR; }
    }
    PG8_WAIT_V(0);
    if constexpr (!ALIGN_EPI) { if (wr == 0) PG8_BAR; }
    PG8_BAR;
    if constexpr (Epi::AFTER_DRAIN) { E.fused(acc, cur, wr, wc, fr, fq, lds, wid, lane); S.done(cur); }
#undef PG8_SA
#undef PG8_SB
#undef PG8_STAGE
#undef PG8_LDA
#undef PG8_LDB
#undef PG8_MMA
#undef PG8_WAIT_V
#undef PG8_WAIT_L
#undef PG8_BAR
#undef PG8_SCHED
}
}

#define LAS __attribute__((address_space(3)))
typedef unsigned short bf16_t;
typedef short bf16x8 __attribute__((ext_vector_type(8)));
typedef float f32x2 __attribute__((ext_vector_type(2)));
typedef float f32x4 __attribute__((ext_vector_type(4)));
typedef float f32x16 __attribute__((ext_vector_type(16)));
typedef unsigned u32x2 __attribute__((ext_vector_type(2)));
typedef unsigned u32x4 __attribute__((ext_vector_type(4)));
typedef __bf16 bf16x2_t __attribute__((ext_vector_type(2)));

constexpr int DM = 1024, MP = 65536, MS = 2048, M = MP + MS, NIN = 1792, FF = 4096;
constexpr float EPS = 1e-5f;
constexpr float LOG2E = 1.4426950408889634f;
constexpr float C2 = 0.125f * LOG2E;
constexpr size_t O_KP = (size_t)M * DM;
constexpr size_t O_VP = O_KP + 2 * 16 * 128 * 128;
constexpr size_t O_CP = O_VP + 2 * 16 * 128 * 128;
constexpr size_t O_KS = O_CP + 2 * 16 * 30 * 512;
constexpr size_t O_VS = O_KS + 2 * 32 * 128 * 128;
constexpr size_t O_CS = O_VS + 2 * 32 * 128 * 128;
constexpr size_t O_END = O_CS + 2 * 32 * 30 * 512;
constexpr size_t MiB = 1u << 20;
constexpr size_t WS_CTL = 0, WS_WIN = 1 * MiB, WS_WOUT = 8 * MiB, WS_WUP = 12 * MiB, WS_WDN = 28 * MiB, WS_SS = 44 * MiB, WS_CK = 49 * MiB, WS_CV = 51 * MiB, WS_SC = 53 * MiB;
constexpr size_t WS_XB = 56 * MiB, WS_H = 188 * MiB, WS_PART = 716 * MiB, WS_END = 780 * MiB;
constexpr size_t WS_Q = WS_H, WS_K = WS_H + 66 * MiB, WS_V = WS_K + 17 * MiB, WS_U = WS_V + 17 * MiB, WS_MIX = WS_U + 66 * MiB;
static_assert(WS_MIX + 132 * MiB <= WS_PART && WS_H + 528 * MiB <= WS_PART, "ws map");
constexpr int LDS_BYTES = 147456;

__device__ __forceinline__ unsigned cvtpk(float lo, float hi) { f32x2 v = {lo, hi}; bf16x2_t b = __builtin_convertvector(v, bf16x2_t); return __builtin_bit_cast(unsigned, b); }
__device__ __forceinline__ float bf_lo(unsigned u) { return __uint_as_float(u << 16); }
__device__ __forceinline__ float bf_hi(unsigned u) { return __uint_as_float(u & 0xffff0000u); }
__device__ __forceinline__ float wave_sum(float v) {
#pragma unroll
    for (int o = 1; o < 64; o <<= 1) v += __shfl_xor(v, o);
    return v;
}
__device__ __forceinline__ float row_rstd(const float* SS, int row) { return __builtin_amdgcn_rsqf(SS[row] * (1.0f / 1024.0f) + EPS); }
__device__ __forceinline__ float sigmoid_f(float x) { return __builtin_amdgcn_rcpf(1.0f + __builtin_amdgcn_exp2f(-LOG2E * x)); }

#define XB_TMO      128
#define XB_XCNT(j)  (256  + 64 * (j))
#define XB_XSUB(j)  (1280 + 64 * (j))
#define XB_XGEN(j)  (2304 + 64 * (j))
#define XB_TOP      3328
#define XB_TOPGEN   3392
#define XCD_BAR_WORDS 3456
#define XB_SPIN_CAP (1u << 18)

__device__ __forceinline__ unsigned xb_ld(unsigned* p)              { return __hip_atomic_load(p, __ATOMIC_RELAXED, __HIP_MEMORY_SCOPE_AGENT); }
__device__ __forceinline__ unsigned xb_add(unsigned* p, unsigned v) { return __hip_atomic_fetch_add(p, v, __ATOMIC_RELAXED, __HIP_MEMORY_SCOPE_AGENT); }
__device__ __forceinline__ unsigned xb_xcc_id() { return (unsigned)__builtin_amdgcn_s_getreg((3 << 11) | 20) & 0xFu; }
#define XB_SPIN(cond, bar) do { unsigned _sp = 0; while (cond) { __builtin_amdgcn_s_sleep(1); \
    if ((++_sp & 255u) == 0u) { if (xb_ld(&(bar)[XB_TMO])) break; if (_sp > XB_SPIN_CAP) { atomicAdd(&(bar)[XB_TMO], 1u); break; } } } } while (0)

struct XcdBarrier {
    unsigned* bar; unsigned x;
    volatile LAS unsigned* st;
};

__device__ __forceinline__ XcdBarrier xcd_barrier_post(unsigned* bar, volatile LAS unsigned* st) {
    XcdBarrier b; b.bar = bar; b.x = xb_xcc_id(); b.st = st;
    if (threadIdx.x == 0) (void)xb_add(&bar[XB_XCNT(b.x)], 1u);
    return b;
}
__device__ __forceinline__ void xcd_barrier_complete(unsigned* bar, unsigned x, unsigned& nloc, unsigned& nx) {
    const unsigned G = gridDim.x * gridDim.y * gridDim.z;
    unsigned sum, cnt, mine, sp = 0u;
    for (;;) {
        sum = 0u; cnt = 0u; mine = 0u;
#pragma unroll
        for (unsigned j = 0; j < 16; ++j) { const unsigned c = xb_ld(&bar[XB_XCNT(j)]); sum += c; cnt += (c > 0u) ? 1u : 0u; mine = (j == x) ? c : mine; }
        if (sum == G) break;
        __builtin_amdgcn_s_sleep(1);
        if ((++sp & 255u) == 0u) { if (xb_ld(&bar[XB_TMO])) break; if (sp > XB_SPIN_CAP) { atomicAdd(&bar[XB_TMO], 1u); break; } }
    }
    nloc = mine > 0u ? mine : 1u; nx = cnt > 0u ? cnt : 1u;
}

__device__ __forceinline__ void xcd_barrier(const XcdBarrier& b) {
    asm volatile("s_waitcnt vmcnt(0)" ::: "memory");
    __syncthreads();
    if (threadIdx.x == 0) {
        unsigned* bar = b.bar;
        __builtin_amdgcn_s_waitcnt(0);
        unsigned nloc = b.st[0], nx = b.st[1];
        if (nloc == 0u) { xcd_barrier_complete(bar, b.x, nloc, nx); b.st[0] = nloc; b.st[1] = nx; }
        const unsigned old = xb_add(&bar[XB_XSUB(b.x)], 1u);
        const unsigned gen = old / nloc;
        if (old + 1u == (gen + 1u) * nloc) {
            __builtin_amdgcn_fence(__ATOMIC_RELEASE, "agent");
            asm volatile("s_waitcnt vmcnt(0)" ::: "memory");
            const unsigned og = xb_add(&bar[XB_TOP], 1u);
            const unsigned tg = og / nx;
            if (og + 1u == (tg + 1u) * nx) xb_add(&bar[XB_TOPGEN], 1u);
            else XB_SPIN(xb_ld(&bar[XB_TOPGEN]) == tg, bar);
            __builtin_amdgcn_fence(__ATOMIC_ACQUIRE, "agent");
            xb_add(&bar[XB_XGEN(b.x)], 1u);
            asm volatile("s_waitcnt vmcnt(0)" ::: "memory");
        } else {
            XB_SPIN(xb_ld(&bar[XB_XGEN(b.x)]) == gen, bar);
            __builtin_amdgcn_fence(__ATOMIC_ACQUIRE, "agent");
            asm volatile("s_waitcnt vmcnt(0)" ::: "memory");
        }
    }
    __syncthreads();
}

constexpr int MISC_OFF = 147200;
constexpr int BAR_WORD0 = 1024;
constexpr size_t CTL_ZERO_BYTES = 65536;

template <class T> __device__ __forceinline__ T* opaque_uniform(T* p) {
    const unsigned long long v = (unsigned long long)p;
    unsigned lo = __builtin_amdgcn_readfirstlane((unsigned)v), hi = __builtin_amdgcn_readfirstlane((unsigned)(v >> 32));
    asm volatile("" : "+s"(lo), "+s"(hi));
    return (T*)(((unsigned long long)hi << 32) | lo);
}

__device__ __forceinline__ unsigned dpp_xor1(unsigned v) { return (unsigned)__builtin_amdgcn_update_dpp(0, (int)v, 0xB1, 0xF, 0xF, true); }
__device__ __forceinline__ u32x4 xor1(u32x4 v) { u32x4 r; r.x = dpp_xor1(v.x); r.y = dpp_xor1(v.y); r.z = dpp_xor1(v.z); r.w = dpp_xor1(v.w); return r; }
__device__ __forceinline__ u32x4 pack8(f32x4 v0, f32x4 v1) { u32x4 w; w.x = cvtpk(v0[0], v0[1]); w.y = cvtpk(v0[2], v0[3]); w.z = cvtpk(v1[0], v1[1]); w.w = cvtpk(v1[2], v1[3]); return w; }
template <bool NT> __device__ __forceinline__ void store_pair(bf16_t* gp, size_t pitch, int fr, int fq, u32x4 c0, u32x4 c1) {
    const bool odd = (fr & 1) != 0;
    const u32x4 x = xor1(odd ? c0 : c1);
    bf16_t* p = gp - (odd ? pitch : 0) + (odd ? 32 : 0) + 8 * fq;
    const u32x4 d0 = odd ? x : c0, d1 = odd ? c1 : x;
    if (NT) { __builtin_nontemporal_store(d0, (u32x4*)p); __builtin_nontemporal_store(d1, (u32x4*)(p + pitch)); }
    else { *(u32x4*)p = d0; *(u32x4*)(p + pitch) = d1; }
}
__device__ __forceinline__ void load_pair(const bf16_t* gp, size_t pitch, int fr, int fq, u32x4& c0, u32x4& c1) {
    const bool odd = (fr & 1) != 0;
    const bf16_t* p = gp - (odd ? pitch : 0) + (odd ? 32 : 0) + 8 * fq;
    const u32x4 d0 = *(const u32x4*)p, d1 = *(const u32x4*)(p + pitch);
    const u32x4 y = xor1(odd ? d0 : d1);
    c0 = odd ? y : d0; c1 = odd ? d1 : y;
}
struct EpiIn {
    static constexpr bool PERM = true, AFTER_DRAIN = false;
    const float* SS; bf16_t* QB; bf16_t* KB; bf16_t* VB; bf16_t* UB; float* out; int layer;
    __device__ __forceinline__ void operator()(const f32x4 (&acc)[2][2][4][2], const pg8::Unit& u, int wr, int wc, int fr, int fq) const {
        const int row0 = u.pm * 256 + wr * 64 + fr;
        float rsd[2][4];
#pragma unroll
        for (int ai = 0; ai < 2; ++ai)
#pragma unroll
            for (int m = 0; m < 4; ++m) rsd[ai][m] = SS[row0 + ai * 128 + m * 16];
#pragma unroll
        for (int ai = 0; ai < 2; ++ai)
#pragma unroll
            for (int m = 0; m < 4; ++m) rsd[ai][m] = __builtin_amdgcn_rsqf(rsd[ai][m] * (1.0f / 1024.0f) + EPS);
        if (u.pn < 2) {
#pragma unroll
            for (int ai = 0; ai < 2; ++ai)
#pragma unroll
                for (int m = 0; m < 4; ++m) {
                    const int row = row0 + ai * 128 + m * 16; const float sc = rsd[ai][m] * C2;
                    store_pair<false>(QB + (size_t)row * 512 + u.pn * 256 + wc * 64, 512, fr, fq, pack8(acc[ai][0][m][0] * sc, acc[ai][0][m][1] * sc), pack8(acc[ai][1][m][0] * sc, acc[ai][1][m][1] * sc));
                }
        } else if (u.pn == 2) {
            bf16_t* T = wc < 2 ? KB : VB; const int cg = (wc & 1) * 64;
#pragma unroll
            for (int ai = 0; ai < 2; ++ai)
#pragma unroll
                for (int m = 0; m < 4; ++m) {
                    const int row = row0 + ai * 128 + m * 16; const float sc = rsd[ai][m];
                    long od = -1;
                    size_t ob = 0;
                    if (row < MP) { const int b = row >> 12, t = row & 4095; if (t >= 3968) { od = (long)((layer * 16 + b) * 128 + (t - 3968)); ob = wc < 2 ? O_KP : O_VP; } }
                    else { const int rs = row - MP, b = rs >> 6, t = rs & 63; od = (long)((layer * 32 + b) * 128 + 64 + t); ob = wc < 2 ? O_KS : O_VS; }
                    const f32x4 a0 = acc[ai][0][m][0] * sc, a1 = acc[ai][0][m][1] * sc, b0 = acc[ai][1][m][0] * sc, b1 = acc[ai][1][m][1] * sc;
                    store_pair<false>(T + (size_t)row * 128 + cg, 128, fr, fq, pack8(a0, a1), pack8(b0, b1));
                    if (od >= 0) { float* o = out + ob + (size_t)od * 128 + cg + 8 * fq; *(f32x4*)o = a0; *(f32x4*)(o + 4) = a1; *(f32x4*)(o + 32) = b0; *(f32x4*)(o + 36) = b1; }
                }
        } else {
            const int ch0 = (u.pn - 3) * 128 + wc * 32 + 8 * fq;
#pragma unroll
            for (int ai = 0; ai < 2; ++ai)
#pragma unroll
                for (int m = 0; m < 4; ++m) {
                    const int row = row0 + ai * 128 + m * 16; const float sc = rsd[ai][m];
                    long od = -1; size_t oc = 0;
                    if (row < MP) { const int b = row >> 12, t = row & 4095; if (t >= 4066) { od = (long)((layer * 16 + b) * 30 + (t - 4066)); oc = O_CP; } }
                    else { const int rs = row - MP, b = rs >> 6, t = rs & 63; if (t >= 34) { od = (long)((layer * 32 + b) * 30 + (t - 34)); oc = O_CS; } }
                    f32x4 u0, u1;
#pragma unroll
                    for (int i = 0; i < 4; ++i) { u0[i] = acc[ai][0][m][0][i] * sc * sigmoid_f(acc[ai][1][m][0][i] * sc); u1[i] = acc[ai][0][m][1][i] * sc * sigmoid_f(acc[ai][1][m][1][i] * sc); }
                    *(u32x4*)(UB + (size_t)row * 512 + ch0) = pack8(u0, u1);
                    if (od >= 0) { float* o = out + oc + (size_t)od * 512 + ch0; *(f32x4*)o = u0; *(f32x4*)(o + 4) = u1; }
                }
        }
    }
};
struct EpiRes {
    static constexpr bool PERM = true, AFTER_DRAIN = false;
    bf16_t* xb; float* SS;
    __device__ __forceinline__ void operator()(const f32x4 (&acc)[2][2][4][2], const pg8::Unit& u, int wr, int wc, int fr, int fq) const {
        const int row0 = u.pm * 256 + wr * 64 + fr, cg = u.pn * 256 + wc * 64;
#pragma unroll
        for (int ai = 0; ai < 2; ++ai)
#pragma unroll
        for (int mh = 0; mh < 2; ++mh) {
            u32x4 r0[2], r1[2];
#pragma unroll
            for (int mm = 0; mm < 2; ++mm) load_pair(xb + (size_t)(row0 + ai * 128 + (mh * 2 + mm) * 16) * DM + cg, DM, fr, fq, r0[mm], r1[mm]);
#pragma unroll
            for (int mm = 0; mm < 2; ++mm) {
                const int m = mh * 2 + mm, row = row0 + ai * 128 + m * 16;
                const f32x4 v0 = acc[ai][0][m][0] + (f32x4){bf_lo(r0[mm].x), bf_hi(r0[mm].x), bf_lo(r0[mm].y), bf_hi(r0[mm].y)}, v1 = acc[ai][0][m][1] + (f32x4){bf_lo(r0[mm].z), bf_hi(r0[mm].z), bf_lo(r0[mm].w), bf_hi(r0[mm].w)};
                const f32x4 w0 = acc[ai][1][m][0] + (f32x4){bf_lo(r1[mm].x), bf_hi(r1[mm].x), bf_lo(r1[mm].y), bf_hi(r1[mm].y)}, w1 = acc[ai][1][m][1] + (f32x4){bf_lo(r1[mm].z), bf_hi(r1[mm].z), bf_lo(r1[mm].w), bf_hi(r1[mm].w)};
                store_pair<false>(xb + (size_t)row * DM + cg, DM, fr, fq, pack8(v0, v1), pack8(w0, w1));
                float sq = (v0[0] * v0[0] + v0[1] * v0[1]) + (v0[2] * v0[2] + v0[3] * v0[3]) + (v1[0] * v1[0] + v1[1] * v1[1]) + (v1[2] * v1[2] + v1[3] * v1[3]);
                sq += (w0[0] * w0[0] + w0[1] * w0[1]) + (w0[2] * w0[2] + w0[3] * w0[3]) + (w1[0] * w1[0] + w1[1] * w1[1]) + (w1[2] * w1[2] + w1[3] * w1[3]);
                sq += __shfl_xor(sq, 16); sq += __shfl_xor(sq, 32);
                if (fq == 0) (void)__hip_atomic_fetch_add(SS + row, sq, __ATOMIC_RELAXED, __HIP_MEMORY_SCOPE_AGENT);
            }
            asm volatile("" ::: "memory");
        }
    }
};
struct EpiUp {
    static constexpr bool PERM = true, AFTER_DRAIN = false;
    const float* SS; bf16_t* HB;
    __device__ __forceinline__ void operator()(const f32x4 (&acc)[2][2][4][2], const pg8::Unit& u, int wr, int wc, int fr, int fq) const {
        const int row0 = u.pm * 256 + wr * 64 + fr, cg = u.pn * 256 + wc * 64;
        float rsd[2][4];
#pragma unroll
        for (int ai = 0; ai < 2; ++ai)
#pragma unroll
            for (int m = 0; m < 4; ++m) rsd[ai][m] = SS[row0 + ai * 128 + m * 16];
#pragma unroll
        for (int ai = 0; ai < 2; ++ai)
#pragma unroll
            for (int m = 0; m < 4; ++m) rsd[ai][m] = __builtin_amdgcn_rsqf(rsd[ai][m] * (1.0f / 1024.0f) + EPS);
#pragma unroll
        for (int ai = 0; ai < 2; ++ai)
#pragma unroll
            for (int m = 0; m < 4; ++m) {
                const int row = row0 + ai * 128 + m * 16; const float sc = rsd[ai][m];
                u32x4 c[2];
#pragma unroll
                for (int bj = 0; bj < 2; ++bj) { f32x4 v0 = acc[ai][bj][m][0] * sc, v1 = acc[ai][bj][m][1] * sc;
#pragma unroll
                    for (int i = 0; i < 4; ++i) { const float a = fmaxf(v0[i], 0.f), b = fmaxf(v1[i], 0.f); v0[i] = a * a; v1[i] = b * b; }
                    c[bj] = pack8(v0, v1); }
                store_pair<true>(HB + (size_t)row * FF + cg, FF, fr, fq, c[0], c[1]);
            }
    }
};

struct EpiPart {
    static constexpr bool PERM = true, AFTER_DRAIN = false;
    float* part;
    __device__ __forceinline__ void operator()(const f32x4 (&acc)[2][2][4][2], const pg8::Unit& u, int wr, int wc, int fr, int fq) const {
        const int row0 = u.pm * 256 + wr * 64 + fr - MP, col0 = u.pn * 256 + wc * 64 + 8 * fq;
        float* base = part + (size_t)u.kz * MS * DM;
#pragma unroll
        for (int ai = 0; ai < 2; ++ai)
#pragma unroll
            for (int m = 0; m < 4; ++m) { float* op = base + (size_t)(row0 + ai * 128 + m * 16) * DM + col0;
#pragma unroll
                for (int bj = 0; bj < 2; ++bj) { *(f32x4*)(op + bj * 32) = acc[ai][bj][m][0]; *(f32x4*)(op + bj * 32 + 4) = acc[ai][bj][m][1]; } }
    }
};
struct EpiAll {
    static constexpr bool PERM = true, AFTER_DRAIN = false;
    int kind, layer, ssr, ssw; unsigned char* ws; float* out;
    __device__ __forceinline__ void operator()(const f32x4 (&acc)[2][2][4][2], const pg8::Unit& u, int wr, int wc, int fr_, int fq_) const {
        int lane = (int)__builtin_amdgcn_mbcnt_hi(~0u, __builtin_amdgcn_mbcnt_lo(~0u, 0u)); asm volatile("" : "+v"(lane));
        const int fr = lane & 15, fq = (lane >> 4) & 3;
        unsigned char* ws = opaque_uniform(this->ws); float* out = opaque_uniform(this->out);
        const float* SS = (const float*)(ws + WS_SS) + (size_t)ssr * M; float* SSW = (float*)(ws + WS_SS) + (size_t)ssw * M;
        if (kind == 0) { EpiIn E{SS, (bf16_t*)(ws + WS_Q), (bf16_t*)(ws + WS_K), (bf16_t*)(ws + WS_V), (bf16_t*)(ws + WS_U), out, layer}; E(acc, u, wr, wc, fr, fq); }
        else if (kind == 1) { EpiRes E{(bf16_t*)(ws + WS_XB), SSW}; E(acc, u, wr, wc, fr, fq); }
        else if (kind == 2) { EpiUp E{SS, (bf16_t*)(ws + WS_H)}; E(acc, u, wr, wc, fr, fq); }
        else if (kind == 3) { EpiPart E{(float*)(ws + WS_PART)}; E(acc, u, wr, wc, fr, fq); }
        else { if (acc[0][0][0][0][0] == 123.456f) out[0] = 0.f; }
    }
};

struct Args { const float* in[17]; float* out; unsigned char* ws; int ph_lo, ph_hi; };
enum { I_XP = 0, I_XS, I_CK, I_CV, I_SC, I_N1, I_WIN, I_SINK, I_CW, I_CB, I_LG, I_LB, I_WOUT, I_N2, I_WUP, I_WDN, I_FN };

struct ItemD { const float* W; const float* g; bf16_t* WT; int K, N, mode, item; };
__device__ __forceinline__ void item_load(const ItemD& d, float (&wv)[32], float (&gv)[32], int lane) {
    const int nblk = d.N / 32, kb = d.item / nblk, nb = d.item % nblk, k0 = 64 * kb, n0 = 32 * nb;
#pragma unroll
    for (int i = 0; i < 32; ++i) { const int kk = 2 * i + (lane >> 5); wv[i] = d.W[(size_t)(k0 + kk) * d.N + n0 + (lane & 31)]; gv[i] = d.g ? d.g[k0 + kk] : 1.0f; }
}
__device__ __forceinline__ void item_finish(const ItemD& d, const float (&wv)[32], const float (&gv)[32], LAS float* scr, int lane) {
    const int nblk = d.N / 32, kb = d.item / nblk, nb = d.item % nblk, k0 = 64 * kb, n0 = 32 * nb, K = d.K;
#pragma unroll
    for (int i = 0; i < 32; ++i) { const int kk = 2 * i + (lane >> 5); scr[kk * 33 + (lane & 31)] = wv[i] * gv[i]; }
    asm volatile("s_waitcnt lgkmcnt(0)" ::: "memory");
    int dn0 = n0;
    if (d.mode == 1 && n0 >= 768) { int c = n0 - 768; const int gofs = c < 512 ? 0 : 32; if (c >= 512) c -= 512; dn0 = 768 + (c >> 7) * 256 + ((c >> 5) & 3) * 64 + gofs + (c & 31); }
    const int c = lane & 7;
#pragma unroll
    for (int j = 0; j < 4; ++j) { const int n = (lane >> 3) + 8 * j; const LAS float* sp = scr + (8 * c) * 33 + n;
        u32x4 o; o.x = cvtpk(sp[0 * 33], sp[1 * 33]); o.y = cvtpk(sp[2 * 33], sp[3 * 33]); o.z = cvtpk(sp[4 * 33], sp[5 * 33]); o.w = cvtpk(sp[6 * 33], sp[7 * 33]);
        *(u32x4*)(d.WT + (size_t)(dn0 + n) * K + k0 + 8 * c) = o; }
    asm volatile("s_waitcnt lgkmcnt(0)" ::: "memory");
}
__device__ __forceinline__ void prologue(LAS unsigned char* lds, const Args& a, const int tid, const int bid) {
    const int lane = tid & 63, wave = __builtin_amdgcn_readfirstlane(tid >> 6), G = gridDim.x;
    const int gw = bid * 8 + wave, NGW = G * 8;
    unsigned char* ws = a.ws;
    LAS float* scr = (LAS float*)(lds + wave * 16384);
    constexpr int I_IN = 16 * (NIN / 32), I_OUT = 16 * (DM / 32), I_UP = 16 * (FF / 32), I_DN = 64 * (DM / 32), I_L = I_IN + I_OUT + I_UP + I_DN;
    auto resolve = [&](int it) -> ItemD {
        const int l = it / I_L; int r = it % I_L;
        if (r < I_IN) return ItemD{a.in[I_WIN] + (size_t)l * DM * NIN, a.in[I_N1] + l * DM, (bf16_t*)(ws + WS_WIN) + (size_t)l * NIN * DM, DM, NIN, 1, r};
        r -= I_IN; if (r < I_OUT) return ItemD{a.in[I_WOUT] + (size_t)l * DM * DM, nullptr, (bf16_t*)(ws + WS_WOUT) + (size_t)l * DM * DM, DM, DM, 0, r};
        r -= I_OUT; if (r < I_UP) return ItemD{a.in[I_WUP] + (size_t)l * DM * FF, a.in[I_N2] + l * DM, (bf16_t*)(ws + WS_WUP) + (size_t)l * FF * DM, DM, FF, 0, r};
        r -= I_UP; return ItemD{a.in[I_WDN] + (size_t)l * FF * DM, nullptr, (bf16_t*)(ws + WS_WDN) + (size_t)l * DM * FF, FF, DM, 0, r};
    };
    {
        float wv[32], gv[32], wn[32], gn[32]; ItemD d, dn;
        int it = gw;
        if (it < 2 * I_L) { d = resolve(it); item_load(d, wv, gv, lane); }
#pragma unroll 1
        for (; it < 2 * I_L; it += NGW) {
            const bool more = it + NGW < 2 * I_L;
            if (more) { dn = resolve(it + NGW); item_load(dn, wn, gn, lane); }
            item_finish(d, wv, gv, scr, lane);
            if (more) { d = dn;
#pragma unroll
                for (int i = 0; i < 32; ++i) { wv[i] = wn[i]; gv[i] = gn[i]; } }
        }
    }
    bf16_t* XB = (bf16_t*)(ws + WS_XB); float* SS = (float*)(ws + WS_SS);
    for (int m0 = gw; m0 < M; m0 += 2 * NGW) {
        const int m1 = m0 + NGW; const bool two = m1 < M; const int m1c = two ? m1 : m0;
        const float* xr0 = m0 < MP ? a.in[I_XP] + (size_t)m0 * DM : a.in[I_XS] + (size_t)(m0 - MP) * DM;
        const float* xr1 = m1c < MP ? a.in[I_XP] + (size_t)m1c * DM : a.in[I_XS] + (size_t)(m1c - MP) * DM;
        const f32x4* xa = (const f32x4*)xr0 + lane; const f32x4* xb_ = (const f32x4*)xr1 + lane;
        f32x4 v[4], w4[4]; float s0 = 0.f, s1 = 0.f;
#pragma unroll
        for (int j = 0; j < 4; ++j) v[j] = xa[64 * j];
#pragma unroll
        for (int j = 0; j < 4; ++j) w4[j] = xb_[64 * j];
#pragma unroll
        for (int j = 0; j < 4; ++j) { s0 += (v[j][0] * v[j][0] + v[j][1] * v[j][1]) + (v[j][2] * v[j][2] + v[j][3] * v[j][3]); s1 += (w4[j][0] * w4[j][0] + w4[j][1] * w4[j][1]) + (w4[j][2] * w4[j][2] + w4[j][3] * w4[j][3]); }
        s0 = wave_sum(s0); s1 = wave_sum(s1);
        u32x2* o0 = (u32x2*)(XB + (size_t)m0 * DM) + lane;
#pragma unroll
        for (int j = 0; j < 4; ++j) { u32x2 w; w.x = cvtpk(v[j][0], v[j][1]); w.y = cvtpk(v[j][2], v[j][3]); o0[64 * j] = w; }
        if (lane < 5) SS[(size_t)lane * M + m0] = lane == 0 ? s0 : 0.f;
        if (two) {
            u32x2* o1 = (u32x2*)(XB + (size_t)m1 * DM) + lane;
#pragma unroll
            for (int j = 0; j < 4; ++j) { u32x2 w; w.x = cvtpk(w4[j][0], w4[j][1]); w.y = cvtpk(w4[j][2], w4[j][3]); o1[64 * j] = w; }
            if (lane < 5) SS[(size_t)lane * M + m1] = lane == 0 ? s1 : 0.f;
        }
    }
    const int gt = bid * 512 + tid, GT = G * 512;
    float* out = a.out;
    for (int i = gt; i < 2 * 32 * 128 * 128 / 4; i += GT) {
        const f32x4 kv = ((const f32x4*)a.in[I_CK])[i], vv = ((const f32x4*)a.in[I_CV])[i];
        u32x2 wk, wv; wk.x = cvtpk(kv[0], kv[1]); wk.y = cvtpk(kv[2], kv[3]); wv.x = cvtpk(vv[0], vv[1]); wv.y = cvtpk(vv[2], vv[3]);
        ((u32x2*)(ws + WS_CK))[i] = wk; ((u32x2*)(ws + WS_CV))[i] = wv;
        const int e = 4 * i, row = (e >> 7) & 127;
        if (row >= 64) { const int lb = e >> 14; const size_t dst = ((size_t)lb * 128 + (row - 64)) * 128 + (e & 127); *(f32x4*)(out + O_KS + dst) = kv; *(f32x4*)(out + O_VS + dst) = vv; }
    }
    for (int i = gt; i < 2 * 32 * 30 * 512 / 4; i += GT) {
        const f32x4 v = ((const f32x4*)a.in[I_SC])[i]; u32x2 w; w.x = cvtpk(v[0], v[1]); w.y = cvtpk(v[2], v[3]); ((u32x2*)(ws + WS_SC))[i] = w;
    }
}

constexpr int CW_OFF = 0, CIN_OFF = 31 * 512 * 4, RED_OFF = CIN_OFF + 62 * 1024;
__device__ __forceinline__ void conv_stage_weights(LAS unsigned char* lds, const float* cw, const int tid) {
    for (int i = tid; i < 31 * 512 / 4; i += 512) *(LAS f32x4*)(lds + CW_OFF + i * 16) = ((const f32x4*)cw)[i];
}
__device__ __forceinline__ size_t conv_row0(int hc, bool& smp, int& c, int& sb) {
    const int gc = hc >> 1, half = hc & 1; smp = gc >= 1024; c = 0; sb = 0; size_t r0;
    if (!smp) { const int b = gc >> 6; c = gc & 63; r0 = (size_t)b * 4096 + c * 64; } else { sb = gc - 1024; r0 = (size_t)MP + sb * 64; }
    return r0 + half * 32;
}
__device__ __forceinline__ void conv_fetch(u32x4 (&rg)[8], const bf16_t* UB, const bf16_t* SCB_l, int hc, const int tid) {
    bool smp; int c, sb; const size_t tok0 = conv_row0(hc, smp, c, sb); const int half = hc & 1;
#pragma unroll
    for (int j = 0; j < 8; ++j) {
        const int idx = tid + 512 * j, i = idx >> 6, pc = idx & 63; u32x4 v = {0u, 0u, 0u, 0u};
        if (idx < 62 * 64) {
            if (half == 1 || i >= 30) v = *(const u32x4*)(UB + (tok0 + i - 30) * 512 + pc * 8);
            else if (smp) v = *(const u32x4*)(SCB_l + ((size_t)sb * 30 + i) * 512 + pc * 8);
            else if (c > 0) v = *(const u32x4*)(UB + (tok0 + i - 30) * 512 + pc * 8);
        }
        rg[j] = v;
    }
}
__device__ __forceinline__ void conv_compute(LAS unsigned char* lds, bf16_t* MIX, const f32x2 (&w)[31], const float* cb, const float* lg, const float* lb, int hc, const int tid) {
    const int lane = tid & 63, wid = __builtin_amdgcn_readfirstlane(tid >> 6);
    bool smp; int c, sb; const size_t tok0 = conv_row0(hc, smp, c, sb);
    const int cp = tid & 255, th = wid >> 2;
#pragma unroll 1
    for (int tg = 0; tg < 2; ++tg) {
        const int t0 = th * 16 + tg * 8;
        f32x2 in[38];
#pragma unroll
        for (int i = 0; i < 38; ++i) { const unsigned u = *(const LAS unsigned*)(lds + CIN_OFF + (t0 + i) * 1024 + cp * 4); in[i] = (f32x2){bf_lo(u), bf_hi(u)}; }
        f32x2 h[8];
        const f32x2 bias = *(const f32x2*)(cb + 2 * cp);
#pragma unroll
        for (int k = 0; k < 8; ++k) h[k] = bias;
#pragma unroll
        for (int j = 0; j < 31; ++j) { const f32x2 wj = w[j];
#pragma unroll
            for (int k = 0; k < 8; ++k) h[k] = wj * in[k + j] + h[k]; }
        float st[16];
#pragma unroll
        for (int k = 0; k < 8; ++k) { st[k] = h[k].x + h[k].y; st[8 + k] = h[k].x * h[k].x + h[k].y * h[k].y; }
        float s8[8], s4[4], s2[2], s1;
        { const bool up = (lane & 32) != 0;
#pragma unroll
          for (int k = 0; k < 8; ++k) { const float keep = up ? st[8 + k] : st[k], send = up ? st[k] : st[8 + k]; s8[k] = keep + __shfl_xor(send, 32); } }
        { const bool up = (lane & 16) != 0;
#pragma unroll
          for (int k = 0; k < 4; ++k) { const float keep = up ? s8[4 + k] : s8[k], send = up ? s8[k] : s8[4 + k]; s4[k] = keep + __shfl_xor(send, 16); } }
        { const bool up = (lane & 8) != 0;
#pragma unroll
          for (int k = 0; k < 2; ++k) { const float keep = up ? s4[2 + k] : s4[k], send = up ? s4[k] : s4[2 + k]; s2[k] = keep + __shfl_xor(send, 8); } }
        { const bool up = (lane & 4) != 0; const float keep = up ? s2[1] : s2[0], send = up ? s2[0] : s2[1]; s1 = keep + __shfl_xor(send, 4); }
        s1 += __shfl_xor(s1, 2); s1 += __shfl_xor(s1, 1);
        if ((lane & 3) == 0) { const int v = ((lane >> 5) & 1) * 8 + ((lane >> 4) & 1) * 4 + ((lane >> 3) & 1) * 2 + ((lane >> 2) & 1);
            *(LAS float*)(lds + RED_OFF + (tg * 8 + wid) * 64 + v * 4) = s1; }
        __syncthreads();
        float tot[16];
#pragma unroll
        for (int k = 0; k < 16; ++k) tot[k] = 0.f;
#pragma unroll
        for (int w4 = 0; w4 < 4; ++w4) { const LAS f32x4* rp = (const LAS f32x4*)(lds + RED_OFF + (tg * 8 + th * 4 + w4) * 64);
#pragma unroll
            for (int q = 0; q < 4; ++q) { const f32x4 v = rp[q]; tot[4 * q] += v[0]; tot[4 * q + 1] += v[1]; tot[4 * q + 2] += v[2]; tot[4 * q + 3] += v[3]; } }
        unsigned* op = (unsigned*)(MIX + (tok0 + t0) * 1024 + 512 + 2 * cp);
        const f32x2 gg = *(const f32x2*)(lg + 2 * cp), bb = *(const f32x2*)(lb + 2 * cp);
#pragma unroll
        for (int k = 0; k < 8; ++k) {
            const float mean = tot[k] * (1.0f / 512.0f), var = tot[8 + k] * (1.0f / 512.0f) - mean * mean;
            const float rstd = __builtin_amdgcn_rsqf(fmaxf(var, 0.f) + EPS);
            f32x2 y = (h[k] - mean) * rstd * gg + bb;
            y.x = y.x * sigmoid_f(y.x); y.y = y.y * sigmoid_f(y.y);
            op[(size_t)k * 512] = cvtpk(y.x, y.y);
        }
    }
}
__device__ __forceinline__ void conv_units(LAS unsigned char* lds, const bf16_t* UB, const bf16_t* SCB_l, bf16_t* MIX, const float* cw, const float* cb, const float* lg, const float* lb, const int tid, const int bid, const int G) {
    f32x2 w[31];
#pragma unroll
    for (int j = 0; j < 31; ++j) w[j] = *(const f32x2*)(cw + j * 512 + 2 * (tid & 255));
    u32x4 rg[8];
    int it = bid;
    if (it < 2112) conv_fetch(rg, UB, SCB_l, it, tid);
#pragma unroll 1
    for (; it < 2112; it += G) {
        __syncthreads();
#pragma unroll
        for (int j = 0; j < 8; ++j) { const int idx = tid + 512 * j; if (idx < 62 * 64) *(LAS u32x4*)(lds + CIN_OFF + (idx >> 6) * 1024 + (idx & 63) * 16) = rg[j]; }
        __syncthreads();
        if (it + G < 2112) conv_fetch(rg, UB, SCB_l, it + G, tid);
        conv_compute(lds, MIX, w, cb, lg, lb, it, tid);
    }
}

__device__ __forceinline__ int crow(int r, int h) { return (r & 3) + 8 * (r >> 2) + 4 * h; }
struct AttnRegs { u32x4 k[3], v[3]; bf16x8 q[4]; };
__device__ __forceinline__ size_t attn_rows(int unit, bool& smp, int& first, int& sb) {
    const int gc = unit >> 1; smp = gc >= 1024; first = 0; sb = 0; size_t qrow0;
    if (!smp) { const int b = gc >> 6, c = gc & 63; qrow0 = (size_t)b * 4096 + c * 64; first = c >= 2 ? 0 : 2 - c; } else { sb = gc - 1024; qrow0 = (size_t)MP + sb * 64; }
    return qrow0;
}
__device__ __forceinline__ void attn_fetch(AttnRegs& R, const bf16_t* QB, const bf16_t* KB, const bf16_t* VB, const bf16_t* CKB_l, const bf16_t* CVB_l, int unit, const int tid) {
    const int lane = tid & 63, wid = __builtin_amdgcn_readfirstlane(tid >> 6), r32 = lane & 31, hi = lane >> 5, kh = unit & 1;
    bool smp; int first, sb; const size_t qrow0 = attn_rows(unit, smp, first, sb);
    { const int kv = tid >> 3, dg = tid & 7;
#pragma unroll
        for (int j = 0; j < 3; ++j) { R.k[j] = (u32x4){0u, 0u, 0u, 0u}; if (j >= first) {
            const bf16_t* src = (smp && j < 2) ? CKB_l + ((size_t)sb * 128 + j * 64) * 128 : KB + (qrow0 + j * 64 - 128) * 128;
            R.k[j] = *(const u32x4*)(src + (size_t)kv * 128 + kh * 64 + dg * 8); } } }
    { const int kv = tid & 63, dg = wid;
#pragma unroll
        for (int j = 0; j < 3; ++j) { R.v[j] = (u32x4){0u, 0u, 0u, 0u}; if (j >= first) {
            const bf16_t* src = (smp && j < 2) ? CVB_l + ((size_t)sb * 128 + j * 64) * 128 : VB + (qrow0 + j * 64 - 128) * 128;
            R.v[j] = *(const u32x4*)(src + (size_t)kv * 128 + kh * 64 + dg * 8); } } }
    const int g = wid >> 1, qh = wid & 1, head = kh * 4 + g;
    const bf16_t* qp = QB + (qrow0 + qh * 32 + r32) * 512 + head * 64 + hi * 8;
#pragma unroll
    for (int d0 = 0; d0 < 4; ++d0) R.q[d0] = *(const bf16x8*)(qp + d0 * 16);
}
constexpr int KOFF = 0, KSTR = 144, VOFF = 192 * 144, VSTR = 400;
__device__ __forceinline__ void attn_stage(LAS unsigned char* lds, const AttnRegs& R, const int tid) {
    const int wid = __builtin_amdgcn_readfirstlane(tid >> 6);
    { const int kv = tid >> 3, dg = tid & 7;
#pragma unroll
        for (int j = 0; j < 3; ++j) *(LAS u32x4*)(lds + KOFF + (j * 64 + kv) * KSTR + dg * 16) = R.k[j]; }
    { const int kv = tid & 63, dg = wid;
#pragma unroll
        for (int j = 0; j < 3; ++j) { const u32x4 v = R.v[j];
            const int w = j * 64 + kv, slot = (w & ~12) | ((w & 4) << 1) | ((w & 8) >> 1);
            LAS unsigned short* dst = (LAS unsigned short*)(lds + VOFF + (dg * 8) * VSTR + slot * 2);
#pragma unroll
            for (int i = 0; i < 8; ++i) dst[i * (VSTR / 2)] = (unsigned short)(v[i >> 1] >> (16 * (i & 1))); } }
}
__device__ __forceinline__ void attn_compute(LAS unsigned char* lds, const bf16x8 (&qf)[4], bf16_t* MIX, const float* sink_l, int unit, const int tid) {
    const int lane = tid & 63, wid = __builtin_amdgcn_readfirstlane(tid >> 6), r32 = lane & 31, hi = lane >> 5, kh = unit & 1;
    bool smp; int first, sb; const size_t qrow0 = attn_rows(unit, smp, first, sb);
    const int g = wid >> 1, qh = wid & 1, head = kh * 4 + g;
    const float sk = sink_l[head] * LOG2E;
    f32x16 p[6];
#pragma unroll
    for (int kt = 0; kt < 6; ++kt) {
        if ((kt >> 1) >= first) {
            f32x16 acc;
#pragma unroll
            for (int i = 0; i < 16; ++i) acc[i] = 0.f;
#pragma unroll
            for (int d0 = 0; d0 < 4; ++d0) { const bf16x8 kf = *(const LAS bf16x8*)(lds + KOFF + (kt * 32 + r32) * KSTR + (d0 * 16 + hi * 8) * 2);
                acc = __builtin_amdgcn_mfma_f32_32x32x16_bf16(kf, qf[d0], acc, 0, 0, 0); }
            p[kt] = acc;
        } else {
#pragma unroll
            for (int i = 0; i < 16; ++i) p[kt][i] = -1e30f;
        }
    }
    float mx = sk;
#pragma unroll
    for (int kt = 0; kt < 6; ++kt)
#pragma unroll
        for (int i = 0; i < 16; ++i) mx = fmaxf(mx, p[kt][i]);
    mx = fmaxf(mx, __shfl_xor(mx, 32));
    float sum = 0.f;
#pragma unroll
    for (int kt = 0; kt < 6; ++kt)
#pragma unroll
        for (int i = 0; i < 16; ++i) { const float e = __builtin_amdgcn_exp2f(p[kt][i] - mx); p[kt][i] = e; sum += e; }
    sum += __shfl_xor(sum, 32);
    const float inv = 1.0f / (sum + __builtin_amdgcn_exp2f(sk - mx));
    f32x16 o0, o1;
#pragma unroll
    for (int i = 0; i < 16; ++i) { o0[i] = 0.f; o1[i] = 0.f; }
#pragma unroll
    for (int kt = 0; kt < 6; ++kt) if ((kt >> 1) >= first) {
#pragma unroll
        for (int s = 0; s < 2; ++s) {
            u32x4 pw; pw.x = cvtpk(p[kt][8 * s] * inv, p[kt][8 * s + 1] * inv); pw.y = cvtpk(p[kt][8 * s + 2] * inv, p[kt][8 * s + 3] * inv);
            pw.z = cvtpk(p[kt][8 * s + 4] * inv, p[kt][8 * s + 5] * inv); pw.w = cvtpk(p[kt][8 * s + 6] * inv, p[kt][8 * s + 7] * inv);
            const bf16x8 pa = __builtin_bit_cast(bf16x8, pw);
            const bf16x8 v0 = *(const LAS bf16x8*)(lds + VOFF + r32 * VSTR + (kt * 32 + s * 16 + hi * 8) * 2);
            const bf16x8 v1 = *(const LAS bf16x8*)(lds + VOFF + (32 + r32) * VSTR + (kt * 32 + s * 16 + hi * 8) * 2);
            o0 = __builtin_amdgcn_mfma_f32_32x32x16_bf16(pa, v0, o0, 0, 0, 0);
            o1 = __builtin_amdgcn_mfma_f32_32x32x16_bf16(pa, v1, o1, 0, 0, 0);
        }
    }
    bf16_t* op = MIX + (qrow0 + qh * 32) * 1024 + head * 64 + r32;
#pragma unroll
    for (int i = 0; i < 16; ++i) { const int q = crow(i, hi);
        op[(size_t)q * 1024] = (bf16_t)(cvtpk(o0[i], 0.f) & 0xffffu); op[(size_t)q * 1024 + 32] = (bf16_t)(cvtpk(o1[i], 0.f) & 0xffffu); }
}
__device__ __forceinline__ void attn_units(LAS unsigned char* lds, const bf16_t* QB, const bf16_t* KB, const bf16_t* VB, const bf16_t* CKB_l, const bf16_t* CVB_l, bf16_t* MIX, const float* sink_l, const int tid, const int bid, const int G) {
    AttnRegs R;
    int it = G - 1 - bid;
    if (it < 2112) attn_fetch(R, QB, KB, VB, CKB_l, CVB_l, it, tid);
#pragma unroll 1
    for (; it < 2112; it += G) {
        __syncthreads();
        attn_stage(lds, R, tid);
        bf16x8 qf[4];
#pragma unroll
        for (int d0 = 0; d0 < 4; ++d0) qf[d0] = R.q[d0];
        __syncthreads();
        if (it + G < 2112) attn_fetch(R, QB, KB, VB, CKB_l, CVB_l, it + G, tid);
        attn_compute(lds, qf, MIX, sink_l, it, tid);
    }
}

__device__ __forceinline__ void combine_sample_rows(unsigned char* ws, int ssw, const int tid, const int bid, const int G) {
    const int lane = tid & 63, wave = tid >> 6, gw = bid * 8 + wave, NGW = G * 8;
    const float* part = (const float*)(ws + WS_PART); bf16_t* XB = (bf16_t*)(ws + WS_XB); float* SS = (float*)(ws + WS_SS) + (size_t)ssw * M;
    for (int r = gw; r < MS; r += NGW) {
        const int row = MP + r; u32x2* o8 = (u32x2*)(XB + (size_t)row * DM) + lane;
        f32x4 v[4];
#pragma unroll
        for (int j = 0; j < 4; ++j) { const u32x2 x = o8[64 * j]; v[j] = (f32x4){bf_lo(x.x), bf_hi(x.x), bf_lo(x.y), bf_hi(x.y)}; }
#pragma unroll
        for (int kz = 0; kz < 8; ++kz) { const f32x4* pp = (const f32x4*)(part + ((size_t)kz * MS + r) * DM) + lane;
#pragma unroll
            for (int j = 0; j < 4; ++j) v[j] += pp[64 * j]; }
        float sq = 0.f;
#pragma unroll
        for (int j = 0; j < 4; ++j) { u32x2 w; w.x = cvtpk(v[j][0], v[j][1]); w.y = cvtpk(v[j][2], v[j][3]); o8[64 * j] = w;
            sq += (v[j][0] * v[j][0] + v[j][1] * v[j][1]) + (v[j][2] * v[j][2] + v[j][3] * v[j][3]); }
        sq = wave_sum(sq);
        if (lane == 0) SS[row] = sq;
    }
}

constexpr int N_PHASES = 14, PPL = 6;
#ifndef MK_PER_PHASE
#define MK_PER_PHASE 0
#endif
#ifndef PROBE_REPEAT_PH
#define PROBE_REPEAT_PH 0
#define PROBE_NREP 0
#endif
#ifndef PROBE_NOEPI
#define PROBE_NOEPI 0
#endif

__device__ __forceinline__ void phase_gemm(LAS unsigned char* lds, unsigned char* ws, float* out, int l, int k, const int tid, const int bid, const int G, const bool noepi = false) {
    const int npass = (k == 4) ? 2 : 1;
#pragma unroll 1
    for (int pass = 0; pass < npass; ++pass) {
        pg8::Gemm g; g.M = M; g.ablk = 0; EpiAll E; E.ssr = 0; E.ssw = 0; E.layer = l; E.ws = ws; E.out = out;
        pg8::StaticOrder S; int rows = M; S.mode = 0;
        if (k == 0)      { g.A = (const bf16_t*)(ws + WS_XB);  g.Bt = (const bf16_t*)(ws + WS_WIN) + (size_t)l * NIN * DM; g.N = NIN; g.K = DM; g.KL = DM; E.kind = 0; E.ssr = 2 * l; }
        else if (k == 2) { g.A = (const bf16_t*)(ws + WS_MIX); g.Bt = (const bf16_t*)(ws + WS_WOUT) + (size_t)l * DM * DM; g.N = DM; g.K = DM; g.KL = DM; E.kind = 1; E.ssw = 2 * l + 1; }
        else if (k == 3) { g.A = (const bf16_t*)(ws + WS_XB);  g.Bt = (const bf16_t*)(ws + WS_WUP) + (size_t)l * FF * DM; g.N = FF; g.K = DM; g.KL = DM; E.kind = 2; E.ssr = 2 * l + 1; }
        else             { g.A = (const bf16_t*)(ws + WS_H);   g.Bt = (const bf16_t*)(ws + WS_WDN) + (size_t)l * DM * FF; g.N = DM; g.K = FF; E.ssw = 2 * l + 2;
                           if (pass == 0) { g.KL = FF; E.kind = 1; rows = MP; }
                           else           { g.KL = FF / 8; E.kind = 3; S.mode = 1; } }
        if (noepi) E.kind = 4;
        S.init(rows, g.N, G, bid);
        pg8::gemm_phase<EpiAll, pg8::StaticOrder, true, true>(lds, g, S, E, tid);
    }
}
__device__ __forceinline__ void phase_mixer(LAS unsigned char* lds, unsigned char* ws, const float* cw, const float* cb, const float* lg, const float* lb, const float* sink, int l, const int tid, const int bid, const int G) {
    bf16_t* QB = (bf16_t*)(ws + WS_Q); bf16_t* KB = (bf16_t*)(ws + WS_K); bf16_t* VB = (bf16_t*)(ws + WS_V); bf16_t* UB = (bf16_t*)(ws + WS_U); bf16_t* MIX = (bf16_t*)(ws + WS_MIX);
    const bf16_t* SCB_l = (const bf16_t*)(ws + WS_SC) + (size_t)l * 32 * 30 * 512;
    const bf16_t* CKB_l = (const bf16_t*)(ws + WS_CK) + (size_t)l * 32 * 128 * 128; const bf16_t* CVB_l = (const bf16_t*)(ws + WS_CV) + (size_t)l * 32 * 128 * 128;
    conv_units(lds, UB, SCB_l, MIX, cw + l * 31 * 512, cb + l * 512, lg + l * 512, lb + l * 512, tid, bid, G);
    attn_units(lds, QB, KB, VB, CKB_l, CVB_l, MIX, sink + l * 8, tid, bid, G);
    __syncthreads();
}
__device__ __forceinline__ void final_row(const float* SS, const bf16_t* XB, const float* part, float* out, const float* fn, int m, int lane) {
    f32x4* p = (f32x4*)(out + (size_t)m * DM) + lane; const f32x4* gp = (const f32x4*)fn + lane; const u32x2* xp = (const u32x2*)(XB + (size_t)m * DM) + lane;
    f32x4 v[4];
#pragma unroll
    for (int j = 0; j < 4; ++j) { const u32x2 x = xp[64 * j]; v[j] = (f32x4){bf_lo(x.x), bf_hi(x.x), bf_lo(x.y), bf_hi(x.y)}; }
    float rs;
    if (m < MP) rs = row_rstd(SS, m);
    else {
        const int r = m - MP;
#pragma unroll
        for (int kz = 0; kz < 8; ++kz) { const f32x4* pp = (const f32x4*)(part + ((size_t)kz * MS + r) * DM) + lane;
#pragma unroll
            for (int j = 0; j < 4; ++j) v[j] += pp[64 * j]; }
        float sq = 0.f;
#pragma unroll
        for (int j = 0; j < 4; ++j) sq += (v[j][0] * v[j][0] + v[j][1] * v[j][1]) + (v[j][2] * v[j][2] + v[j][3] * v[j][3]);
        rs = __builtin_amdgcn_rsqf(wave_sum(sq) * (1.0f / 1024.0f) + EPS);
    }
#pragma unroll
    for (int j = 0; j < 4; ++j) p[64 * j] = v[j] * rs * gp[64 * j];
}
__device__ __forceinline__ void phase_final(unsigned char* ws, float* out, const float* fn, const int tid, const int bid, const int G) {
    const float* SS = (const float*)(ws + WS_SS) + (size_t)4 * M; const bf16_t* XB = (const bf16_t*)(ws + WS_XB); const float* part = (const float*)(ws + WS_PART);
    const int lane = tid & 63, wave = tid >> 6, gw = bid * 8 + wave, NGW = G * 8;
    for (int m0 = gw; m0 < M; m0 += 4 * NGW) {
        if (m0 + 3 * NGW < MP) {
            u32x2 x[4][4]; float ss[4];
#pragma unroll
            for (int r = 0; r < 4; ++r) { const u32x2* xp = (const u32x2*)(XB + (size_t)(m0 + r * NGW) * DM) + lane;
#pragma unroll
                for (int j = 0; j < 4; ++j) x[r][j] = xp[64 * j];
                ss[r] = SS[m0 + r * NGW]; }
            f32x4 g4[4];
#pragma unroll
            for (int j = 0; j < 4; ++j) g4[j] = ((const f32x4*)fn + lane)[64 * j];
#pragma unroll
            for (int r = 0; r < 4; ++r) { const float rs = __builtin_amdgcn_rsqf(ss[r] * (1.0f / 1024.0f) + EPS); f32x4* p = (f32x4*)(out + (size_t)(m0 + r * NGW) * DM) + lane;
#pragma unroll
                for (int j = 0; j < 4; ++j) { const f32x4 v = {bf_lo(x[r][j].x), bf_hi(x[r][j].x), bf_lo(x[r][j].y), bf_hi(x[r][j].y)}; p[64 * j] = v * rs * g4[j]; } }
        } else {
            for (int r = 0; r < 4; ++r) { const int m = m0 + r * NGW; if (m < M) final_row(SS, XB, part, out, fn, m, lane); }
        }
    }
}

#if MK_PER_PHASE
template <int KIND> __global__ void __launch_bounds__(512, 2) phase_kernel(Args a, int ph) {
    extern __shared__ __attribute__((aligned(16))) unsigned char lds_raw[];
    LAS unsigned char* lds = (LAS unsigned char*)lds_raw;
    unsigned char* ws = a.ws; float* out = a.out;
    const int G = gridDim.x, tid = threadIdx.x, bid = blockIdx.x;
    const bool noepi = ph >= 100; if (noepi) ph -= 100;
    const int l = (ph - 1) / PPL, k = (ph - 1) % PPL;
    if constexpr (KIND == 0) prologue(lds, a, tid, bid);
    else if constexpr (KIND == 3) phase_final(ws, out, a.in[I_FN], tid, bid, G);
    else if constexpr (KIND == 4) combine_sample_rows(ws, 2 * l + 2, tid, bid, G);
    else if constexpr (KIND == 2) phase_mixer(lds, ws, a.in[I_CW], a.in[I_CB], a.in[I_LG], a.in[I_LB], a.in[I_SINK], l, tid, bid, G);
    else phase_gemm(lds, ws, out, l, k, tid, bid, G, noepi);
}
#else
__global__ void __launch_bounds__(512, 2) fwd_megakernel(Args a_unused) {
    extern __shared__ __attribute__((aligned(16))) unsigned char lds_raw[];
    LAS unsigned char* lds = (LAS unsigned char*)lds_raw;
    cg::grid_group grid = cg::this_grid();
    const Args* ap0 = (const Args*)__builtin_amdgcn_kernarg_segment_ptr();
    const int ph_lo = ap0->ph_lo, ph_hi = ap0->ph_hi;
    if (threadIdx.x < 64) ((LAS unsigned*)(lds + MISC_OFF))[threadIdx.x] = 0u;
    __syncthreads();
    const int wave_id = __builtin_amdgcn_readfirstlane((int)(threadIdx.x >> 6));
    const XcdBarrier xbar = xcd_barrier_post((unsigned*)(ap0->ws + WS_CTL) + BAR_WORD0, (volatile LAS unsigned*)(lds + MISC_OFF));
#pragma unroll 1
    for (int ph = ph_lo; ph < ph_hi; ++ph) {
        const Args* ap = (const Args*)__builtin_amdgcn_kernarg_segment_ptr(); asm volatile("" : "+s"(ap));
        unsigned char* ws = opaque_uniform(ap->ws); float* out = opaque_uniform(ap->out);
        const int G = gridDim.x;
        int tid = wave_id * 64 + (int)__builtin_amdgcn_mbcnt_hi(~0u, __builtin_amdgcn_mbcnt_lo(~0u, 0u)), bid = blockIdx.x;
        asm volatile("" : "+v"(tid)); asm volatile("" : "+s"(bid)); tid &= 511; bid &= 1023;
        const int l = (ph - 1) / PPL, k = (ph - 1) % PPL;
        if (ph == N_PHASES - 2) continue;
        if (ph == 0) {
            Args a;
#pragma unroll
            for (int i = 0; i < 17; ++i) a.in[i] = ap->in[i];
            a.out = out; a.ws = ws; a.ph_lo = 0; a.ph_hi = 0;
            prologue(lds, a, tid, bid);
        } else if (ph == N_PHASES - 1) phase_final(ws, out, opaque_uniform(ap->in[I_FN]), tid, bid, G);
        else if (k == 1) phase_mixer(lds, ws, opaque_uniform(ap->in[I_CW]), opaque_uniform(ap->in[I_CB]), opaque_uniform(ap->in[I_LG]), opaque_uniform(ap->in[I_LB]), opaque_uniform(ap->in[I_SINK]), l, tid, bid, G);
        else if (k == 5) combine_sample_rows(ws, 2 * l + 2, tid, bid, G);
        else phase_gemm(lds, ws, out, l, k, tid, bid, G);
        if (ph + 1 < ph_hi) { XcdBarrier b = xbar; asm volatile("" : "+s"(b.x)); xcd_barrier(b);
            if (ph == ph_lo && xb_ld(&b.bar[XB_TMO]) != 0u) grid.sync(); }
    }
}
#endif

extern "C" void kernel_launch(void* const* d_in, const int* in_sizes, int n_in, void* d_out, int out_size, void* d_ws, size_t ws_size, hipStream_t stream) {
    static int grid = 0;
    if (grid == 0) {
        if (n_in != 17 || (size_t)out_size != O_END || ws_size < WS_END) { fprintf(stderr, "kernel_launch: unexpected shapes: n_in %d out %d ws %zu (need %zu)\n", n_in, out_size, ws_size, (size_t)WS_END); grid = -1; return; }
        int dev = 0, cus = 0, per_cu = 0;
        if (hipGetDevice(&dev) != hipSuccess || hipDeviceGetAttribute(&cus, hipDeviceAttributeMultiprocessorCount, dev) != hipSuccess) { grid = -1; return; }
#if MK_PER_PHASE
        if (hipFuncSetAttribute((const void*)phase_kernel<0>, hipFuncAttributeMaxDynamicSharedMemorySize, LDS_BYTES) != hipSuccess || hipFuncSetAttribute((const void*)phase_kernel<1>, hipFuncAttributeMaxDynamicSharedMemorySize, LDS_BYTES) != hipSuccess ||
            hipFuncSetAttribute((const void*)phase_kernel<2>, hipFuncAttributeMaxDynamicSharedMemorySize, LDS_BYTES) != hipSuccess || hipFuncSetAttribute((const void*)phase_kernel<3>, hipFuncAttributeMaxDynamicSharedMemorySize, LDS_BYTES) != hipSuccess ||
            hipFuncSetAttribute((const void*)phase_kernel<4>, hipFuncAttributeMaxDynamicSharedMemorySize, LDS_BYTES) != hipSuccess) { fprintf(stderr, "kernel_launch: hipFuncSetAttribute failed\n"); grid = -1; return; }
        (void)per_cu;
#else
        if (hipFuncSetAttribute((const void*)fwd_megakernel, hipFuncAttributeMaxDynamicSharedMemorySize, LDS_BYTES) != hipSuccess) { fprintf(stderr, "kernel_launch: hipFuncSetAttribute failed\n"); grid = -1; return; }
        if (hipOccupancyMaxActiveBlocksPerMultiprocessor(&per_cu, (const void*)fwd_megakernel, 512, LDS_BYTES) != hipSuccess || per_cu < 1) { fprintf(stderr, "kernel_launch: occupancy query says %d\n", per_cu); per_cu = 1; }
#endif
        (void)hipGetLastError();
        grid = cus;
    }
    if (grid < 0) return;
    Args a{};
    for (int i = 0; i < 17; ++i) a.in[i] = (const float*)d_in[i];
    a.out = (float*)d_out; a.ws = (unsigned char*)d_ws;
#if MK_PER_PHASE
    for (int ph0 = 0; ph0 < N_PHASES + PROBE_NREP; ++ph0) {
        const int ph = ph0 <= PROBE_REPEAT_PH ? ph0 : (ph0 <= PROBE_REPEAT_PH + PROBE_NREP ? PROBE_REPEAT_PH : ph0 - PROBE_NREP);
        const int k = (ph - 1) % PPL;
        if (ph == N_PHASES - 2) continue;
        if (ph == 0) hipLaunchKernelGGL(phase_kernel<0>, dim3(grid), dim3(512), LDS_BYTES, stream, a, ph);
        else if (ph == N_PHASES - 1) hipLaunchKernelGGL(phase_kernel<3>, dim3(grid), dim3(512), LDS_BYTES, stream, a, ph);
        else if (k == 1) hipLaunchKernelGGL(phase_kernel<2>, dim3(grid), dim3(512), LDS_BYTES, stream, a, ph);
        else if (k == 5) hipLaunchKernelGGL(phase_kernel<4>, dim3(grid), dim3(512), LDS_BYTES, stream, a, ph);
        else hipLaunchKernelGGL(phase_kernel<1>, dim3(grid), dim3(512), LDS_BYTES, stream, a, (PROBE_NOEPI && ph0 > PROBE_REPEAT_PH && ph0 <= PROBE_REPEAT_PH + PROBE_NREP) ? ph + 100 : ph);
    }
#else
    a.ph_lo = 0; a.ph_hi = N_PHASES;
    if (hipMemsetAsync((char*)d_ws + WS_CTL, 0, CTL_ZERO_BYTES, stream) != hipSuccess) { fprintf(stderr, "kernel_launch: hipMemsetAsync failed\n"); return; }
    void* kargs[] = {&a};
    const hipError_t e = hipLaunchCooperativeKernel((const void*)fwd_megakernel, dim3(grid), dim3(512), kargs, LDS_BYTES, stream);
    if (e != hipSuccess) fprintf(stderr, "kernel_launch: cooperative launch failed: %s (grid %d)\n", hipGetErrorString(e), grid);
#endif
}
```

```cpp
#include <hip/hip_runtime.h>
#include <hip/hip_cooperative_groups.h>
#include <cstdio>
#include <cstdint>
namespace cg = cooperative_groups;
namespace pg8 {
#define PG8_LAS __attribute__((address_space(3)))
typedef unsigned short bf16_t;
typedef short bf16x8 __attribute__((ext_vector_type(8)));
typedef float f32x4 __attribute__((ext_vector_type(4)));
typedef unsigned u32x4 __attribute__((ext_vector_type(4)));
constexpr int BM = 256, BK = 64, HALF = 128, HTB = HALF * BK * 2  , STAGE_BYTES = 8 * HTB, NXCD = 8, WGM = 8;

__host__ __device__ __forceinline__ int lds_byte(int r, int c) { const int st = (r >> 4) * 2 + (c >> 5), rr = r & 15, cc = c & 31, ob = rr * 64 + cc * 2; return st * 1024 + (ob ^ (((ob >> 9) & 1) << 5)); }
__host__ __device__ __forceinline__ void stage_rc(int b, int& R, int& C) { const int st = b / 1024, sb = b % 1024, swz = sb ^ (((sb >> 9) & 1) << 5); R = (st >> 1) * 16 + swz / 64; C = (st & 1) * 32 + (swz % 64) / 2; }
__host__ __device__ __forceinline__ int perm32(int rho) { const int n = rho >> 4, i = rho & 15; return 8 * (i >> 2) + 4 * n + (i & 3); }

struct Unit { int pm, pn, kz; };
struct Gemm { const bf16_t* A; const bf16_t* Bt; int M, N, K, KL, ablk; };

struct StaticOrder {
    int nM, nN, nwg, G, c;
    __host__ __device__ void init(int M, int N, int G_, int c_) { nM = M / BM; nN = N / BM; nwg = nM * nN; G = G_; c = c_; }
    __host__ __device__ bool next(int i, Unit& u) const {
        const long L = (long)i * G + c; if (L >= nwg) return false;
        int wgid = (int)L; { const int q = nwg / NXCD, r = nwg % NXCD, xcd = wgid % NXCD, off = wgid / NXCD; wgid = (xcd < r ? xcd * (q + 1) : r * (q + 1) + (xcd - r) * q) + off; }
        const int wgm = nN >= 7 ? 4 : WGM;
        const int nig = wgm * nN, gid = wgid / nig, fm = gid * wgm, gsz = (nM - fm) < wgm ? (nM - fm) : wgm;
        u.pm = fm + ((wgid % nig) % gsz); u.pn = (wgid % nig) / gsz; u.kz = 0; return true;
    }
    int mode;
    __host__ __device__ bool next_any(int i, Unit& u) const {
        if (mode == 0) return next(i, u);
        const int p = i * G + c; if (p >= 256) return false;
        u.kz = p & 7; const int t = p >> 3; u.pm = 256 + (t >> 2); u.pn = t & 3; return true;
    }
    __device__ __forceinline__ void a_ready(const Unit&) const {}
    __device__ __forceinline__ void done(const Unit&) const {}
};

__device__ __forceinline__ unsigned cvt_pk_bf16(float lo, float hi) { unsigned r; asm volatile("v_cvt_pk_bf16_f32 %0, %1, %2" : "=v"(r) : "v"(lo), "v"(hi)); return r; }
template <class Epi, class Sched, bool ALIGN_EPI = false, bool SP2 = false>
__device__ __forceinline__ void gemm_phase(PG8_LAS unsigned char* lds, const Gemm g, const Sched& S, const Epi& E, const int tid_in) {
    const int tid = tid_in, wid = __builtin_amdgcn_readfirstlane(tid >> 6), lane = tid & 63, wr = wid >> 2, wc = wid & 3, fr = lane & 15, fq = lane >> 4;
    const int K = g.K, nt = g.KL / BK;
    const int pitchA = g.ablk ? BK : K;
    unsigned voffA[2], voffB[2];
#pragma unroll
    for (int i = 0; i < 2; ++i) { int R, C; stage_rc(tid * 16 + i * 8192, R, C); const int Rb = Epi::PERM ? ((R >> 5) * 64 + perm32(R & 31)) : R;
        voffA[i] = (unsigned)(R * pitchA + C) * 2u; voffB[i] = (unsigned)(Rb * K + C) * 2u; }
    const size_t kstep = (size_t)(BK * 2);
    const size_t hstep = (size_t)HALF * K * 2;
    const size_t tstep = 2 * hstep;
    const size_t hstepB = Epi::PERM ? (size_t)32 * K * 2 : hstep;
    const size_t kstepA = g.ablk ? (size_t)(BM * BK * 2) : kstep, hstepA = g.ablk ? (size_t)(HALF * BK * 2) : hstep, tstepA = g.ablk ? (size_t)(K / BK) * (size_t)(BM * BK * 2) : tstep;
    const unsigned ldsw = (unsigned)wid * 1024u;
    const int aoff = lds_byte(wr * 64 + fr, fq * 8), boff = lds_byte(wc * 32 + fr, fq * 8);
#define PG8_SA(b, h) (((b) * 2 + (h)) * HTB)
#define PG8_SB(b, h) ((4 + (b) * 2 + (h)) * HTB)
#define PG8_STAGE(bufoff, gbase, voff) do { _Pragma("unroll") for (int _i = 0; _i < 2; ++_i) \
        __builtin_amdgcn_global_load_lds((const unsigned*)((const char*)(gbase) + (voff)[_i]), (PG8_LAS unsigned*)(lds + (bufoff) + ldsw + _i * 8192), 16, 0, 0); } while (0)
#define PG8_LDA(dst, b, h) do { _Pragma("unroll") for (int m = 0; m < 4; ++m) _Pragma("unroll") for (int k = 0; k < 2; ++k) dst[m][k] = *(const PG8_LAS bf16x8*)(lds + PG8_SA(b, h) + aoff + m * 2048 + k * 1024); } while (0)
#define PG8_LDB(dst, b, h) do { _Pragma("unroll") for (int n = 0; n < 2; ++n) _Pragma("unroll") for (int k = 0; k < 2; ++k) dst[n][k] = *(const PG8_LAS bf16x8*)(lds + PG8_SB(b, h) + boff + n * 2048 + k * 1024); } while (0)
#define PG8_MMA(ai, bj, At, Bt) do { __builtin_amdgcn_s_setprio(1); _Pragma("unroll") for (int m = 0; m < 4; ++m) _Pragma("unroll") for (int n = 0; n < 2; ++n) _Pragma("unroll") for (int k = 0; k < 2; ++k) \
        acc[ai][bj][m][n] = __builtin_amdgcn_mfma_f32_16x16x32_bf16(Bt[n][k], At[m][k], acc[ai][bj][m][n], 0, 0, 0); __builtin_amdgcn_s_setprio(0); } while (0)
#define PG8_WAIT_V(n) asm volatile("s_waitcnt vmcnt(" #n ")" ::: "memory")
#define PG8_WAIT_L(n) asm volatile("s_waitcnt lgkmcnt(" #n ")" ::: "memory")
#define PG8_BAR __builtin_amdgcn_s_barrier()
#define PG8_SCHED __builtin_amdgcn_sched_barrier(0)
    Unit cur, nxt; int ui = 0;
    if (!S.next_any(0, cur)) return;
    f32x4 acc[2][2][4][2];
#pragma unroll
    for (int a = 0; a < 2; ++a)
#pragma unroll
        for (int b = 0; b < 2; ++b)
#pragma unroll
            for (int m = 0; m < 4; ++m)
#pragma unroll
                for (int n = 0; n < 2; ++n) acc[a][b][m][n] = (f32x4){0.f, 0.f, 0.f, 0.f};
    bf16x8 At[4][2], B0[2][2], B1[2][2];
    const char* cA = (const char*)g.A + (size_t)cur.pm * tstepA + (size_t)cur.kz * nt * kstepA; const char* cB = (const char*)g.Bt + (size_t)cur.pn * tstep + (size_t)cur.kz * g.KL * 2;
    S.a_ready(cur);
    if constexpr (SP2) {
        PG8_STAGE(PG8_SB(0, 0), cB, voffB); PG8_STAGE(PG8_SB(0, 1), cB + hstepB, voffB); PG8_STAGE(PG8_SA(0, 0), cA, voffA); PG8_STAGE(PG8_SA(0, 1), cA + hstepA, voffA);
        if (wr == 1) PG8_BAR;
        PG8_WAIT_V(2); PG8_BAR;
        PG8_STAGE(PG8_SB(1, 0), cB + kstep, voffB); PG8_STAGE(PG8_SA(1, 0), cA + kstepA, voffA); PG8_STAGE(PG8_SB(1, 1), cB + hstepB + kstep, voffB);
        PG8_WAIT_V(6); PG8_BAR;
    } else {
        PG8_STAGE(PG8_SB(0, 0), cB, voffB); PG8_STAGE(PG8_SA(0, 0), cA, voffA); PG8_STAGE(PG8_SB(0, 1), cB + hstepB, voffB); PG8_STAGE(PG8_SA(0, 1), cA + hstepA, voffA);
        if (wr == 1) PG8_BAR;
        PG8_WAIT_V(4); PG8_BAR;
        PG8_STAGE(PG8_SB(1, 0), cB + kstep, voffB); PG8_STAGE(PG8_SA(1, 0), cA + kstepA, voffA); PG8_STAGE(PG8_SB(1, 1), cB + hstepB + kstep, voffB);
        PG8_WAIT_V(6); PG8_BAR;
    }
    for (;;) {
        const bool has_next = S.next_any(ui + 1, nxt);
        const char* nA = has_next ? (const char*)g.A + (size_t)nxt.pm * tstepA + (size_t)nxt.kz * nt * kstepA : cA; const char* nB = has_next ? (const char*)g.Bt + (size_t)nxt.pn * tstep + (size_t)nxt.kz * g.KL * 2 : cB;
        for (int t = 0; t < nt; t += 2) {
            const bool last = (t == nt - 2);
            const char* a1 = cA + (size_t)(t + 1) * kstepA;
            const char* a2 = last ? nA : cA + (size_t)(t + 2) * kstepA; const char* b2 = last ? nB : cB + (size_t)(t + 2) * kstep;
            const char* a3 = a2 + kstepA; const char* b3 = b2 + kstep;
            if (last && has_next) S.a_ready(nxt);
            if constexpr (SP2) {
            PG8_LDB(B0, 0, 0); PG8_LDB(B1, 0, 1); PG8_SCHED; PG8_LDA(At, 0, 0); PG8_STAGE(PG8_SA(1, 1), a1 + hstepA, voffA);
            PG8_WAIT_V(8); PG8_WAIT_L(0); PG8_BAR; PG8_MMA(0, 0, At, B0); PG8_MMA(0, 1, At, B1); PG8_BAR; PG8_SCHED;
            PG8_LDA(At, 0, 1); PG8_STAGE(PG8_SB(0, 0), b2, voffB); PG8_STAGE(PG8_SB(0, 1), b2 + hstepB, voffB); PG8_STAGE(PG8_SA(0, 0), a2, voffA);
            PG8_WAIT_V(8); PG8_WAIT_L(0); PG8_BAR; PG8_MMA(1, 0, At, B0); PG8_MMA(1, 1, At, B1); PG8_BAR; PG8_SCHED;
            PG8_LDB(B0, 1, 0); PG8_LDB(B1, 1, 1); PG8_SCHED; PG8_LDA(At, 1, 0); PG8_STAGE(PG8_SA(0, 1), a2 + hstepA, voffA);
            PG8_WAIT_V(8); PG8_WAIT_L(0); PG8_BAR; PG8_MMA(0, 0, At, B0); PG8_MMA(0, 1, At, B1); PG8_BAR; PG8_SCHED;
            PG8_LDA(At, 1, 1); PG8_STAGE(PG8_SB(1, 0), b3, voffB); PG8_STAGE(PG8_SB(1, 1), b3 + hstepB, voffB); PG8_STAGE(PG8_SA(1, 0), a3, voffA);
            PG8_WAIT_V(8); PG8_WAIT_L(0); PG8_BAR; PG8_MMA(1, 0, At, B0); PG8_MMA(1, 1, At, B1); PG8_BAR; PG8_SCHED;
            } else {
            PG8_LDB(B0, 0, 0); PG8_SCHED; PG8_LDA(At, 0, 0); PG8_STAGE(PG8_SA(1, 1), a1 + hstepA, voffA);
            PG8_WAIT_L(8); PG8_BAR; PG8_WAIT_L(0); PG8_MMA(0, 0, At, B0); PG8_BAR; PG8_SCHED;
            PG8_LDB(B1, 0, 1); PG8_STAGE(PG8_SB(0, 0), b2, voffB);
            PG8_BAR; PG8_WAIT_L(0); PG8_MMA(0, 1, At, B1); PG8_BAR;
            PG8_LDA(At, 0, 1); PG8_STAGE(PG8_SA(0, 0), a2, voffA);
            PG8_BAR; PG8_WAIT_L(0); PG8_MMA(1, 0, At, B0); PG8_BAR; PG8_SCHED;
            PG8_STAGE(PG8_SB(0, 1), b2 + hstepB, voffB);
            PG8_WAIT_V(6); PG8_BAR; PG8_MMA(1, 1, At, B1); PG8_BAR;
            PG8_LDB(B0, 1, 0); PG8_SCHED; PG8_LDA(At, 1, 0); PG8_STAGE(PG8_SA(0, 1), a2 + hstepA, voffA);
            PG8_WAIT_L(8); PG8_BAR; PG8_WAIT_L(0); PG8_MMA(0, 0, At, B0); PG8_BAR; PG8_SCHED;
            PG8_LDB(B1, 1, 1); PG8_STAGE(PG8_SB(1, 0), b3, voffB);
            PG8_BAR; PG8_WAIT_L(0); PG8_MMA(0, 1, At, B1); PG8_BAR;
            PG8_LDA(At, 1, 1); PG8_STAGE(PG8_SA(1, 0), a3, voffA);
            PG8_BAR; PG8_WAIT_L(0); PG8_MMA(1, 0, At, B0); PG8_BAR; PG8_SCHED;
            PG8_STAGE(PG8_SB(1, 1), b3 + hstepB, voffB);
            PG8_WAIT_V(6); PG8_BAR; PG8_MMA(1, 1, At, B1); PG8_BAR;
            }
        }
        if constexpr (ALIGN_EPI) { if (wr == 0) PG8_BAR; }
        if constexpr (!Epi::AFTER_DRAIN) { E(acc, cur, wr, wc, fr, fq); S.done(cur); }
        if (!has_next) break;
#pragma unroll
        for (int a = 0; a < 2; ++a)
#pragma unroll
            for (int b = 0; b < 2; ++b)
#pragma unroll
                for (int m = 0; m < 4; ++m)
#pragma unroll
                    for (int n = 0; n < 2; ++n) acc[a][b][m][n] = (f32x4){0.f, 0.f, 0.f, 0.f};
        cur = nxt; cA = nA; cB = nB; ++ui;
        if constexpr (ALIGN_EPI) { if (wr == 1) PG8_BAR; }
    }
    PG8_WAIT_V(0);
    if constexpr (!ALIGN_EPI) { if (wr == 0) PG8_BAR; }
    PG8_BAR;
    if constexpr (Epi::AFTER_DRAIN) { E.fused(acc, cur, wr, wc, fr, fq, lds, wid, lane); S.done(cur); }
#undef PG8_SA
#undef PG8_SB
#undef PG8_STAGE
#undef PG8_LDA
#undef PG8_LDB
#undef PG8_MMA
#undef PG8_WAIT_V
#undef PG8_WAIT_L
#undef PG8_BAR
#undef PG8_SCHED
}
}

#define LAS __attribute__((address_space(3)))
typedef unsigned short bf16_t;
typedef short bf16x8 __attribute__((ext_vector_type(8)));
typedef float f32x2 __attribute__((ext_vector_type(2)));
typedef float f32x4 __attribute__((ext_vector_type(4)));
typedef float f32x16 __attribute__((ext_vector_type(16)));
typedef unsigned u32x2 __attribute__((ext_vector_type(2)));
typedef unsigned u32x4 __attribute__((ext_vector_type(4)));
typedef __bf16 bf16x2_t __attribute__((ext_vector_type(2)));

constexpr int DM = 1024, MP = 65536, MS = 2048, M = MP + MS, NIN = 1792, FF = 4096;
constexpr float EPS = 1e-5f;
constexpr float LOG2E = 1.4426950408889634f;
constexpr float C2 = 0.125f * LOG2E;
constexpr size_t O_KP = (size_t)M * DM;
constexpr size_t O_VP = O_KP + 2 * 16 * 128 * 128;
constexpr size_t O_CP = O_VP + 2 * 16 * 128 * 128;
constexpr size_t O_KS = O_CP + 2 * 16 * 30 * 512;
constexpr size_t O_VS = O_KS + 2 * 32 * 128 * 128;
constexpr size_t O_CS = O_VS + 2 * 32 * 128 * 128;
constexpr size_t O_END = O_CS + 2 * 32 * 30 * 512;
constexpr size_t MiB = 1u << 20;
constexpr size_t WS_CTL = 0, WS_WIN = 1 * MiB, WS_WOUT = 8 * MiB, WS_WUP = 12 * MiB, WS_WDN = 28 * MiB, WS_SS = 44 * MiB, WS_CK = 49 * MiB, WS_CV = 51 * MiB, WS_SC = 53 * MiB;
constexpr size_t WS_XB = 56 * MiB, WS_H = 188 * MiB, WS_PART = 716 * MiB, WS_END = 780 * MiB;
constexpr size_t WS_Q = WS_H, WS_K = WS_H + 66 * MiB, WS_V = WS_K + 17 * MiB, WS_U = WS_V + 17 * MiB, WS_MIX = WS_U + 66 * MiB;
static_assert(WS_MIX + 132 * MiB <= WS_PART && WS_H + 528 * MiB <= WS_PART, "ws map");
constexpr int LDS_BYTES = 147456;

__device__ __forceinline__ unsigned cvtpk(float lo, float hi) { f32x2 v = {lo, hi}; bf16x2_t b = __builtin_convertvector(v, bf16x2_t); return __builtin_bit_cast(unsigned, b); }
__device__ __forceinline__ float bf_lo(unsigned u) { return __uint_as_float(u << 16); }
__device__ __forceinline__ float bf_hi(unsigned u) { return __uint_as_float(u & 0xffff0000u); }
__device__ __forceinline__ float wave_sum(float v) {
#pragma unroll
    for (int o = 1; o < 64; o <<= 1) v += __shfl_xor(v, o);
    return v;
}
__device__ __forceinline__ float row_rstd(const float* SS, int row) { return __builtin_amdgcn_rsqf(SS[row] * (1.0f / 1024.0f) + EPS); }
__device__ __forceinline__ float sigmoid_f(float x) { return __builtin_amdgcn_rcpf(1.0f + __builtin_amdgcn_exp2f(-LOG2E * x)); }

#define XB_TMO      128
#define XB_XCNT(j)  (256  + 64 * (j))
#define XB_XSUB(j)  (1280 + 64 * (j))
#define XB_XGEN(j)  (2304 + 64 * (j))
#define XB_TOP      3328
#define XB_TOPGEN   3392
#define XCD_BAR_WORDS 3456
#define XB_SPIN_CAP (1u << 18)

__device__ __forceinline__ unsigned xb_ld(unsigned* p)              { return __hip_atomic_load(p, __ATOMIC_RELAXED, __HIP_MEMORY_SCOPE_AGENT); }
__device__ __forceinline__ unsigned xb_add(unsigned* p, unsigned v) { return __hip_atomic_fetch_add(p, v, __ATOMIC_RELAXED, __HIP_MEMORY_SCOPE_AGENT); }
__device__ __forceinline__ unsigned xb_xcc_id() { return (unsigned)__builtin_amdgcn_s_getreg((3 << 11) | 20) & 0xFu; }
#define XB_SPIN(cond, bar) do { unsigned _sp = 0; while (cond) { __builtin_amdgcn_s_sleep(1); \
    if ((++_sp & 255u) == 0u) { if (xb_ld(&(bar)[XB_TMO])) break; if (_sp > XB_SPIN_CAP) { atomicAdd(&(bar)[XB_TMO], 1u); break; } } } } while (0)

struct XcdBarrier {
    unsigned* bar; unsigned x;
    volatile LAS unsigned* st;
};

__device__ __forceinline__ XcdBarrier xcd_barrier_post(unsigned* bar, volatile LAS unsigned* st) {
    XcdBarrier b; b.bar = bar; b.x = xb_xcc_id(); b.st = st;
    if (threadIdx.x == 0) (void)xb_add(&bar[XB_XCNT(b.x)], 1u);
    return b;
}
__device__ __forceinline__ void xcd_barrier_complete(unsigned* bar, unsigned x, unsigned& nloc, unsigned& nx) {
    const unsigned G = gridDim.x * gridDim.y * gridDim.z;
    unsigned sum, cnt, mine, sp = 0u;
    for (;;) {
        sum = 0u; cnt = 0u; mine = 0u;
#pragma unroll
        for (unsigned j = 0; j < 16; ++j) { const unsigned c = xb_ld(&bar[XB_XCNT(j)]); sum += c; cnt += (c > 0u) ? 1u : 0u; mine = (j == x) ? c : mine; }
        if (sum == G) break;
        __builtin_amdgcn_s_sleep(1);
        if ((++sp & 255u) == 0u) { if (xb_ld(&bar[XB_TMO])) break; if (sp > XB_SPIN_CAP) { atomicAdd(&bar[XB_TMO], 1u); break; } }
    }
    nloc = mine > 0u ? mine : 1u; nx = cnt > 0u ? cnt : 1u;
}

__device__ __forceinline__ void xcd_barrier(const XcdBarrier& b) {
    asm volatile("s_waitcnt vmcnt(0)" ::: "memory");
    __syncthreads();
    if (threadIdx.x == 0) {
        unsigned* bar = b.bar;
        __builtin_amdgcn_s_waitcnt(0);
        unsigned nloc = b.st[0], nx = b.st[1];
        if (nloc == 0u) { xcd_barrier_complete(bar, b.x, nloc, nx); b.st[0] = nloc; b.st[1] = nx; }
        const unsigned old = xb_add(&bar[XB_XSUB(b.x)], 1u);
        const unsigned gen = old / nloc;
        if (old + 1u == (gen + 1u) * nloc) {
            __builtin_amdgcn_fence(__ATOMIC_RELEASE, "agent");
            asm volatile("s_waitcnt vmcnt(0)" ::: "memory");
            const unsigned og = xb_add(&bar[XB_TOP], 1u);
            const unsigned tg = og / nx;
            if (og + 1u == (tg + 1u) * nx) xb_add(&bar[XB_TOPGEN], 1u);
            else XB_SPIN(xb_ld(&bar[XB_TOPGEN]) == tg, bar);
            __builtin_amdgcn_fence(__ATOMIC_ACQUIRE, "agent");
            xb_add(&bar[XB_XGEN(b.x)], 1u);
            asm volatile("s_waitcnt vmcnt(0)" ::: "memory");
        } else {
            XB_SPIN(xb_ld(&bar[XB_XGEN(b.x)]) == gen, bar);
            __builtin_amdgcn_fence(__ATOMIC_ACQUIRE, "agent");
            asm volatile("s_waitcnt vmcnt(0)" ::: "memory");
        }
    }
    __syncthreads();
}

constexpr int MISC_OFF = 147200;
constexpr int BAR_WORD0 = 1024;
constexpr size_t CTL_ZERO_BYTES = 65536;

template <class T> __device__ __forceinline__ T* opaque_uniform(T* p) {
    const unsigned long long v = (unsigned long long)p;
    unsigned lo = __builtin_amdgcn_readfirstlane((unsigned)v), hi = __builtin_amdgcn_readfirstlane((unsigned)(v >> 32));
    asm volatile("" : "+s"(lo), "+s"(hi));
    return (T*)(((unsigned long long)hi << 32) | lo);
}

__device__ __forceinline__ unsigned dpp_xor1(unsigned v) { return (unsigned)__builtin_amdgcn_update_dpp(0, (int)v, 0xB1, 0xF, 0xF, true); }
__device__ __forceinline__ u32x4 xor1(u32x4 v) { u32x4 r; r.x = dpp_xor1(v.x); r.y = dpp_xor1(v.y); r.z = dpp_xor1(v.z); r.w = dpp_xor1(v.w); return r; }
__device__ __forceinline__ u32x4 pack8(f32x4 v0, f32x4 v1) { u32x4 w; w.x = cvtpk(v0[0], v0[1]); w.y = cvtpk(v0[2], v0[3]); w.z = cvtpk(v1[0], v1[1]); w.w = cvtpk(v1[2], v1[3]); return w; }
template <bool NT> __device__ __forceinline__ void store_pair(bf16_t* gp, size_t pitch, int fr, int fq, u32x4 c0, u32x4 c1) {
    const bool odd = (fr & 1) != 0;
    const u32x4 x = xor1(odd ? c0 : c1);
    bf16_t* p = gp - (odd ? pitch : 0) + (odd ? 32 : 0) + 8 * fq;
    const u32x4 d0 = odd ? x : c0, d1 = odd ? c1 : x;
    if (NT) { __builtin_nontemporal_store(d0, (u32x4*)p); __builtin_nontemporal_store(d1, (u32x4*)(p + pitch)); }
    else { *(u32x4*)p = d0; *(u32x4*)(p + pitch) = d1; }
}
__device__ __forceinline__ void load_pair(const bf16_t* gp, size_t pitch, int fr, int fq, u32x4& c0, u32x4& c1) {
    const bool odd = (fr & 1) != 0;
    const bf16_t* p = gp - (odd ? pitch : 0) + (odd ? 32 : 0) + 8 * fq;
    const u32x4 d0 = *(const u32x4*)p, d1 = *(const u32x4*)(p + pitch);
    const u32x4 y = xor1(odd ? d0 : d1);
    c0 = odd ? y : d0; c1 = odd ? d1 : y;
}
struct EpiIn {
    static constexpr bool PERM = true, AFTER_DRAIN = false;
    const float* SS; bf16_t* QB; bf16_t* KB; bf16_t* VB; bf16_t* UB; float* out; int layer;
    __device__ __forceinline__ void operator()(const f32x4 (&acc)[2][2][4][2], const pg8::Unit& u, int wr, int wc, int fr, int fq) const {
        const int row0 = u.pm * 256 + wr * 64 + fr;
        float rsd[2][4];
#pragma unroll
        for (int ai = 0; ai < 2; ++ai)
#pragma unroll
            for (int m = 0; m < 4; ++m) rsd[ai][m] = SS[row0 + ai * 128 + m * 16];
#pragma unroll
        for (int ai = 0; ai < 2; ++ai)
#pragma unroll
            for (int m = 0; m < 4; ++m) rsd[ai][m] = __builtin_amdgcn_rsqf(rsd[ai][m] * (1.0f / 1024.0f) + EPS);
        if (u.pn < 2) {
#pragma unroll
            for (int ai = 0; ai < 2; ++ai)
#pragma unroll
                for (int m = 0; m < 4; ++m) {
                    const int row = row0 + ai * 128 + m * 16; const float sc = rsd[ai][m] * C2;
                    store_pair<false>(QB + (size_t)row * 512 + u.pn * 256 + wc * 64, 512, fr, fq, pack8(acc[ai][0][m][0] * sc, acc[ai][0][m][1] * sc), pack8(acc[ai][1][m][0] * sc, acc[ai][1][m][1] * sc));
                }
        } else if (u.pn == 2) {
            bf16_t* T = wc < 2 ? KB : VB; const int cg = (wc & 1) * 64;
#pragma unroll
            for (int ai = 0; ai < 2; ++ai)
#pragma unroll
                for (int m = 0; m < 4; ++m) {
                    const int row = row0 + ai * 128 + m * 16; const float sc = rsd[ai][m];
                    long od = -1;
                    size_t ob = 0;
                    if (row < MP) { const int b = row >> 12, t = row & 4095; if (t >= 3968) { od = (long)((layer * 16 + b) * 128 + (t - 3968)); ob = wc < 2 ? O_KP : O_VP; } }
                    else { const int rs = row - MP, b = rs >> 6, t = rs & 63; od = (long)((layer * 32 + b) * 128 + 64 + t); ob = wc < 2 ? O_KS : O_VS; }
                    const f32x4 a0 = acc[ai][0][m][0] * sc, a1 = acc[ai][0][m][1] * sc, b0 = acc[ai][1][m][0] * sc, b1 = acc[ai][1][m][1] * sc;
                    store_pair<false>(T + (size_t)row * 128 + cg, 128, fr, fq, pack8(a0, a1), pack8(b0, b1));
                    if (od >= 0) { float* o = out + ob + (size_t)od * 128 + cg + 8 * fq; *(f32x4*)o = a0; *(f32x4*)(o + 4) = a1; *(f32x4*)(o + 32) = b0; *(f32x4*)(o + 36) = b1; }
                }
        } else {
            const int ch0 = (u.pn - 3) * 128 + wc * 32 + 8 * fq;
#pragma unroll
            for (int ai = 0; ai < 2; ++ai)
#pragma unroll
                for (int m = 0; m < 4; ++m) {
                    const int row = row0 + ai * 128 + m * 16; const float sc = rsd[ai][m];
                    long od = -1; size_t oc = 0;
                    if (row < MP) { const int b = row >> 12, t = row & 4095; if (t >= 4066) { od = (long)((layer * 16 + b) * 30 + (t - 4066)); oc = O_CP; } }
                    else { const int rs = row - MP, b = rs >> 6, t = rs & 63; if (t >= 34) { od = (long)((layer * 32 + b) * 30 + (t - 34)); oc = O_CS; } }
                    f32x4 u0, u1;
#pragma unroll
                    for (int i = 0; i < 4; ++i) { u0[i] = acc[ai][0][m][0][i] * sc * sigmoid_f(acc[ai][1][m][0][i] * sc); u1[i] = acc[ai][0][m][1][i] * sc * sigmoid_f(acc[ai][1][m][1][i] * sc); }
                    *(u32x4*)(UB + (size_t)row * 512 + ch0) = pack8(u0, u1);
                    if (od >= 0) { float* o = out + oc + (size_t)od * 512 + ch0; *(f32x4*)o = u0; *(f32x4*)(o + 4) = u1; }
                }
        }
    }
};
struct EpiRes {
    static constexpr bool PERM = true, AFTER_DRAIN = false;
    bf16_t* xb; float* SS;
    __device__ __forceinline__ void operator()(const f32x4 (&acc)[2][2][4][2], const pg8::Unit& u, int wr, int wc, int fr, int fq) const {
        const int row0 = u.pm * 256 + wr * 64 + fr, cg = u.pn * 256 + wc * 64;
#pragma unroll
        for (int ai = 0; ai < 2; ++ai)
#pragma unroll
        for (int mh = 0; mh < 2; ++mh) {
            u32x4 r0[2], r1[2];
#pragma unroll
            for (int mm = 0; mm < 2; ++mm) load_pair(xb + (size_t)(row0 + ai * 128 + (mh * 2 + mm) * 16) * DM + cg, DM, fr, fq, r0[mm], r1[mm]);
#pragma unroll
            for (int mm = 0; mm < 2; ++mm) {
                const int m = mh * 2 + mm, row = row0 + ai * 128 + m * 16;
                const f32x4 v0 = acc[ai][0][m][0] + (f32x4){bf_lo(r0[mm].x), bf_hi(r0[mm].x), bf_lo(r0[mm].y), bf_hi(r0[mm].y)}, v1 = acc[ai][0][m][1] + (f32x4){bf_lo(r0[mm].z), bf_hi(r0[mm].z), bf_lo(r0[mm].w), bf_hi(r0[mm].w)};
                const f32x4 w0 = acc[ai][1][m][0] + (f32x4){bf_lo(r1[mm].x), bf_hi(r1[mm].x), bf_lo(r1[mm].y), bf_hi(r1[mm].y)}, w1 = acc[ai][1][m][1] + (f32x4){bf_lo(r1[mm].z), bf_hi(r1[mm].z), bf_lo(r1[mm].w), bf_hi(r1[mm].w)};
                store_pair<false>(xb + (size_t)row * DM + cg, DM, fr, fq, pack8(v0, v1), pack8(w0, w1));
                float sq = (v0[0] * v0[0] + v0[1] * v0[1]) + (v0[2] * v0[2] + v0[3] * v0[3]) + (v1[0] * v1[0] + v1[1] * v1[1]) + (v1[2] * v1[2] + v1[3] * v1[3]);
                sq += (w0[0] * w0[0] + w0[1] * w0[1]) + (w0[2] * w0[2] + w0[3] * w0[3]) + (w1[0] * w1[0] + w1[1] * w1[1]) + (w1[2] * w1[2] + w1[3] * w1[3]);
                sq += __shfl_xor(sq, 16); sq += __shfl_xor(sq, 32);
                if (fq == 0) (void)__hip_atomic_fetch_add(SS + row, sq, __ATOMIC_RELAXED, __HIP_MEMORY_SCOPE_AGENT);
            }
            asm volatile("" ::: "memory");
        }
    }
};
struct EpiUp {
    static constexpr bool PERM = true, AFTER_DRAIN = false;
    const float* SS; bf16_t* HB;
    __device__ __forceinline__ void operator()(const f32x4 (&acc)[2][2][4][2], const pg8::Unit& u, int wr, int wc, int fr, int fq) const {
        const int row0 = u.pm * 256 + wr * 64 + fr, cg = u.pn * 256 + wc * 64;
        float rsd[2][4];
#pragma unroll
        for (int ai = 0; ai < 2; ++ai)
#pragma unroll
            for (int m = 0; m < 4; ++m) rsd[ai][m] = SS[row0 + ai * 128 + m * 16];
#pragma unroll
        for (int ai = 0; ai < 2; ++ai)
#pragma unroll
            for (int m = 0; m < 4; ++m) rsd[ai][m] = __builtin_amdgcn_rsqf(rsd[ai][m] * (1.0f / 1024.0f) + EPS);
#pragma unroll
        for (int ai = 0; ai < 2; ++ai)
#pragma unroll
            for (int m = 0; m < 4; ++m) {
                const int row = row0 + ai * 128 + m * 16; const float sc = rsd[ai][m];
                u32x4 c[2];
#pragma unroll
                for (int bj = 0; bj < 2; ++bj) { f32x4 v0 = acc[ai][bj][m][0] * sc, v1 = acc[ai][bj][m][1] * sc;
#pragma unroll
                    for (int i = 0; i < 4; ++i) { const float a = fmaxf(v0[i], 0.f), b = fmaxf(v1[i], 0.f); v0[i] = a * a; v1[i] = b * b; }
                    c[bj] = pack8(v0, v1); }
                store_pair<true>(HB + (size_t)row * FF + cg, FF, fr, fq, c[0], c[1]);
            }
    }
};

struct EpiPart {
    static constexpr bool PERM = true, AFTER_DRAIN = false;
    float* part;
    __device__ __forceinline__ void operator()(const f32x4 (&acc)[2][2][4][2], const pg8::Unit& u, int wr, int wc, int fr, int fq) const {
        const int row0 = u.pm * 256 + wr * 64 + fr - MP, col0 = u.pn * 256 + wc * 64 + 8 * fq;
        float* base = part + (size_t)u.kz * MS * DM;
#pragma unroll
        for (int ai = 0; ai < 2; ++ai)
#pragma unroll
            for (int m = 0; m < 4; ++m) { float* op = base + (size_t)(row0 + ai * 128 + m * 16) * DM + col0;
#pragma unroll
                for (int bj = 0; bj < 2; ++bj) { *(f32x4*)(op + bj * 32) = acc[ai][bj][m][0]; *(f32x4*)(op + bj * 32 + 4) = acc[ai][bj][m][1]; } }
    }
};
struct EpiAll {
    static constexpr bool PERM = true, AFTER_DRAIN = false;
    int kind, layer, ssr, ssw; unsigned char* ws; float* out;
    __device__ __forceinline__ void operator()(const f32x4 (&acc)[2][2][4][2], const pg8::Unit& u, int wr, int wc, int fr_, int fq_) const {
        int lane = (int)__builtin_amdgcn_mbcnt_hi(~0u, __builtin_amdgcn_mbcnt_lo(~0u, 0u)); asm volatile("" : "+v"(lane));
        const int fr = lane & 15, fq = (lane >> 4) & 3;
        unsigned char* ws = opaque_uniform(this->ws); float* out = opaque_uniform(this->out);
        const float* SS = (const float*)(ws + WS_SS) + (size_t)ssr * M; float* SSW = (float*)(ws + WS_SS) + (size_t)ssw * M;
        if (kind == 0) { EpiIn E{SS, (bf16_t*)(ws + WS_Q), (bf16_t*)(ws + WS_K), (bf16_t*)(ws + WS_V), (bf16_t*)(ws + WS_U), out, layer}; E(acc, u, wr, wc, fr, fq); }
        else if (kind == 1) { EpiRes E{(bf16_t*)(ws + WS_XB), SSW}; E(acc, u, wr, wc, fr, fq); }
        else if (kind == 2) { EpiUp E{SS, (bf16_t*)(ws + WS_H)}; E(acc, u, wr, wc, fr, fq); }
        else if (kind == 3) { EpiPart E{(float*)(ws + WS_PART)}; E(acc, u, wr, wc, fr, fq); }
        else { if (acc[0][0][0][0][0] == 123.456f) out[0] = 0.f; }
    }
};

struct Args { const float* in[17]; float* out; unsigned char* ws; int ph_lo, ph_hi; };
enum { I_XP = 0, I_XS, I_CK, I_CV, I_SC, I_N1, I_WIN, I_SINK, I_CW, I_CB, I_LG, I_LB, I_WOUT, I_N2, I_WUP, I_WDN, I_FN };

__device__ __forceinline__ void transpose_item(const float* W, int K, int N, bf16_t* WT, const float* g, int mode, LAS float* scr, int item, int lane) {
    const int nblk = N / 32, kb = item / nblk, nb = item % nblk, k0 = 64 * kb, n0 = 32 * nb;
    float wv[32], gv[32];
#pragma unroll
    for (int i = 0; i < 32; ++i) { const int kk = 2 * i + (lane >> 5); wv[i] = W[(size_t)(k0 + kk) * N + n0 + (lane & 31)]; gv[i] = g ? g[k0 + kk] : 1.0f; }
#pragma unroll
    for (int i = 0; i < 32; ++i) { const int kk = 2 * i + (lane >> 5); scr[kk * 33 + (lane & 31)] = wv[i] * gv[i]; }
    asm volatile("s_waitcnt lgkmcnt(0)" ::: "memory");
    int dn0 = n0;
    if (mode == 1 && n0 >= 768) { int c = n0 - 768; const int gofs = c < 512 ? 0 : 32; if (c >= 512) c -= 512; dn0 = 768 + (c >> 7) * 256 + ((c >> 5) & 3) * 64 + gofs + (c & 31); }
    const int c = lane & 7;
#pragma unroll
    for (int j = 0; j < 4; ++j) { const int n = (lane >> 3) + 8 * j; const LAS float* s = scr + (8 * c) * 33 + n;
        u32x4 o; o.x = cvtpk(s[0 * 33], s[1 * 33]); o.y = cvtpk(s[2 * 33], s[3 * 33]); o.z = cvtpk(s[4 * 33], s[5 * 33]); o.w = cvtpk(s[6 * 33], s[7 * 33]);
        *(u32x4*)(WT + (size_t)(dn0 + n) * K + k0 + 8 * c) = o; }
    asm volatile("s_waitcnt lgkmcnt(0)" ::: "memory");
}
__device__ __forceinline__ void prologue(LAS unsigned char* lds, const Args& a, const int tid, const int bid) {
    const int lane = tid & 63, wave = __builtin_amdgcn_readfirstlane(tid >> 6), G = gridDim.x;
    const int gw = bid * 8 + wave, NGW = G * 8;
    unsigned char* ws = a.ws;
    LAS float* scr = (LAS float*)(lds + wave * 16384);
    constexpr int I_IN = 16 * (NIN / 32), I_OUT = 16 * (DM / 32), I_UP = 16 * (FF / 32), I_DN = 64 * (DM / 32), I_L = I_IN + I_OUT + I_UP + I_DN;
    for (int it = gw; it < 2 * I_L; it += NGW) {
        const int l = it / I_L; int r = it % I_L;
        if (r < I_IN) { transpose_item(a.in[I_WIN] + (size_t)l * DM * NIN, DM, NIN, (bf16_t*)(ws + WS_WIN) + (size_t)l * NIN * DM, a.in[I_N1] + l * DM, 1, scr, r, lane); continue; } r -= I_IN;
        if (r < I_OUT) { transpose_item(a.in[I_WOUT] + (size_t)l * DM * DM, DM, DM, (bf16_t*)(ws + WS_WOUT) + (size_t)l * DM * DM, nullptr, 0, scr, r, lane); continue; } r -= I_OUT;
        if (r < I_UP) { transpose_item(a.in[I_WUP] + (size_t)l * DM * FF, DM, FF, (bf16_t*)(ws + WS_WUP) + (size_t)l * FF * DM, a.in[I_N2] + l * DM, 0, scr, r, lane); continue; } r -= I_UP;
        transpose_item(a.in[I_WDN] + (size_t)l * FF * DM, FF, DM, (bf16_t*)(ws + WS_WDN) + (size_t)l * DM * FF, nullptr, 0, scr, r, lane);
    }
    bf16_t* XB = (bf16_t*)(ws + WS_XB); float* SS = (float*)(ws + WS_SS);
    for (int m0 = gw; m0 < M; m0 += 2 * NGW) {
        const int m1 = m0 + NGW; const bool two = m1 < M; const int m1c = two ? m1 : m0;
        const float* xr0 = m0 < MP ? a.in[I_XP] + (size_t)m0 * DM : a.in[I_XS] + (size_t)(m0 - MP) * DM;
        const float* xr1 = m1c < MP ? a.in[I_XP] + (size_t)m1c * DM : a.in[I_XS] + (size_t)(m1c - MP) * DM;
        const f32x4* xa = (const f32x4*)xr0 + lane; const f32x4* xb_ = (const f32x4*)xr1 + lane;
        f32x4 v[4], w4[4]; float s0 = 0.f, s1 = 0.f;
#pragma unroll
        for (int j = 0; j < 4; ++j) v[j] = __builtin_nontemporal_load(xa + 64 * j);
#pragma unroll
        for (int j = 0; j < 4; ++j) w4[j] = __builtin_nontemporal_load(xb_ + 64 * j);
#pragma unroll
        for (int j = 0; j < 4; ++j) { s0 += (v[j][0] * v[j][0] + v[j][1] * v[j][1]) + (v[j][2] * v[j][2] + v[j][3] * v[j][3]); s1 += (w4[j][0] * w4[j][0] + w4[j][1] * w4[j][1]) + (w4[j][2] * w4[j][2] + w4[j][3] * w4[j][3]); }
        s0 = wave_sum(s0); s1 = wave_sum(s1);
        u32x2* o0 = (u32x2*)(XB + (size_t)m0 * DM) + lane;
#pragma unroll
        for (int j = 0; j < 4; ++j) { u32x2 w; w.x = cvtpk(v[j][0], v[j][1]); w.y = cvtpk(v[j][2], v[j][3]); o0[64 * j] = w; }
        if (lane < 5) SS[(size_t)lane * M + m0] = lane == 0 ? s0 : 0.f;
        if (two) {
            u32x2* o1 = (u32x2*)(XB + (size_t)m1 * DM) + lane;
#pragma unroll
            for (int j = 0; j < 4; ++j) { u32x2 w; w.x = cvtpk(w4[j][0], w4[j][1]); w.y = cvtpk(w4[j][2], w4[j][3]); o1[64 * j] = w; }
            if (lane < 5) SS[(size_t)lane * M + m1] = lane == 0 ? s1 : 0.f;
        }
    }
    const int gt = bid * 512 + tid, GT = G * 512;
    float* out = a.out;
    for (int i = gt; i < 2 * 32 * 128 * 128 / 4; i += GT) {
        const f32x4 kv = ((const f32x4*)a.in[I_CK])[i], vv = ((const f32x4*)a.in[I_CV])[i];
        u32x2 wk, wv; wk.x = cvtpk(kv[0], kv[1]); wk.y = cvtpk(kv[2], kv[3]); wv.x = cvtpk(vv[0], vv[1]); wv.y = cvtpk(vv[2], vv[3]);
        ((u32x2*)(ws + WS_CK))[i] = wk; ((u32x2*)(ws + WS_CV))[i] = wv;
        const int e = 4 * i, row = (e >> 7) & 127;
        if (row >= 64) { const int lb = e >> 14; const size_t dst = ((size_t)lb * 128 + (row - 64)) * 128 + (e & 127); *(f32x4*)(out + O_KS + dst) = kv; *(f32x4*)(out + O_VS + dst) = vv; }
    }
    for (int i = gt; i < 2 * 32 * 30 * 512 / 4; i += GT) {
        const f32x4 v = ((const f32x4*)a.in[I_SC])[i]; u32x2 w; w.x = cvtpk(v[0], v[1]); w.y = cvtpk(v[2], v[3]); ((u32x2*)(ws + WS_SC))[i] = w;
    }
}

constexpr int CW_OFF = 0, CIN_OFF = 31 * 512 * 4, RED_OFF = CIN_OFF + 62 * 1024;
__device__ __forceinline__ void conv_stage_weights(LAS unsigned char* lds, const float* cw, const int tid) {
    for (int i = tid; i < 31 * 512 / 4; i += 512) *(LAS f32x4*)(lds + CW_OFF + i * 16) = ((const f32x4*)cw)[i];
}
__device__ __forceinline__ size_t conv_row0(int hc, bool& smp, int& c, int& sb) {
    const int gc = hc >> 1, half = hc & 1; smp = gc >= 1024; c = 0; sb = 0; size_t r0;
    if (!smp) { const int b = gc >> 6; c = gc & 63; r0 = (size_t)b * 4096 + c * 64; } else { sb = gc - 1024; r0 = (size_t)MP + sb * 64; }
    return r0 + half * 32;
}
__device__ __forceinline__ void conv_fetch(u32x4 (&rg)[8], const bf16_t* UB, const bf16_t* SCB_l, int hc, const int tid) {
    bool smp; int c, sb; const size_t tok0 = conv_row0(hc, smp, c, sb); const int half = hc & 1;
#pragma unroll
    for (int j = 0; j < 8; ++j) {
        const int idx = tid + 512 * j, i = idx >> 6, pc = idx & 63; u32x4 v = {0u, 0u, 0u, 0u};
        if (idx < 62 * 64) {
            if (half == 1 || i >= 30) v = *(const u32x4*)(UB + (tok0 + i - 30) * 512 + pc * 8);
            else if (smp) v = *(const u32x4*)(SCB_l + ((size_t)sb * 30 + i) * 512 + pc * 8);
            else if (c > 0) v = *(const u32x4*)(UB + (tok0 + i - 30) * 512 + pc * 8);
        }
        rg[j] = v;
    }
}
__device__ __forceinline__ void conv_compute(LAS unsigned char* lds, bf16_t* MIX, const f32x2 (&w)[31], const float* cb, const float* lg, const float* lb, int hc, const int tid) {
    const int lane = tid & 63, wid = __builtin_amdgcn_readfirstlane(tid >> 6);
    bool smp; int c, sb; const size_t tok0 = conv_row0(hc, smp, c, sb);
    const int cp = tid & 255, th = wid >> 2;
#pragma unroll 1
    for (int tg = 0; tg < 2; ++tg) {
        const int t0 = th * 16 + tg * 8;
        f32x2 in[38];
#pragma unroll
        for (int i = 0; i < 38; ++i) { const unsigned u = *(const LAS unsigned*)(lds + CIN_OFF + (t0 + i) * 1024 + cp * 4); in[i] = (f32x2){bf_lo(u), bf_hi(u)}; }
        f32x2 h[8];
        const f32x2 bias = *(const f32x2*)(cb + 2 * cp);
#pragma unroll
        for (int k = 0; k < 8; ++k) h[k] = bias;
#pragma unroll
        for (int j = 0; j < 31; ++j) { const f32x2 wj = w[j];
#pragma unroll
            for (int k = 0; k < 8; ++k) h[k] = wj * in[k + j] + h[k]; }
        float st[16];
#pragma unroll
        for (int k = 0; k < 8; ++k) { st[k] = h[k].x + h[k].y; st[8 + k] = h[k].x * h[k].x + h[k].y * h[k].y; }
        float s8[8], s4[4], s2[2], s1;
        { const bool up = (lane & 32) != 0;
#pragma unroll
          for (int k = 0; k < 8; ++k) { const float keep = up ? st[8 + k] : st[k], send = up ? st[k] : st[8 + k]; s8[k] = keep + __shfl_xor(send, 32); } }
        { const bool up = (lane & 16) != 0;
#pragma unroll
          for (int k = 0; k < 4; ++k) { const float keep = up ? s8[4 + k] : s8[k], send = up ? s8[k] : s8[4 + k]; s4[k] = keep + __shfl_xor(send, 16); } }
        { const bool up = (lane & 8) != 0;
#pragma unroll
          for (int k = 0; k < 2; ++k) { const float keep = up ? s4[2 + k] : s4[k], send = up ? s4[k] : s4[2 + k]; s2[k] = keep + __shfl_xor(send, 8); } }
        { const bool up = (lane & 4) != 0; const float keep = up ? s2[1] : s2[0], send = up ? s2[0] : s2[1]; s1 = keep + __shfl_xor(send, 4); }
        s1 += __shfl_xor(s1, 2); s1 += __shfl_xor(s1, 1);
        if ((lane & 3) == 0) { const int v = ((lane >> 5) & 1) * 8 + ((lane >> 4) & 1) * 4 + ((lane >> 3) & 1) * 2 + ((lane >> 2) & 1);
            *(LAS float*)(lds + RED_OFF + (tg * 8 + wid) * 64 + v * 4) = s1; }
        __syncthreads();
        float tot[16];
#pragma unroll
        for (int k = 0; k < 16; ++k) tot[k] = 0.f;
#pragma unroll
        for (int w4 = 0; w4 < 4; ++w4) { const LAS f32x4* rp = (const LAS f32x4*)(lds + RED_OFF + (tg * 8 + th * 4 + w4) * 64);
#pragma unroll
            for (int q = 0; q < 4; ++q) { const f32x4 v = rp[q]; tot[4 * q] += v[0]; tot[4 * q + 1] += v[1]; tot[4 * q + 2] += v[2]; tot[4 * q + 3] += v[3]; } }
        unsigned* op = (unsigned*)(MIX + (tok0 + t0) * 1024 + 512 + 2 * cp);
        const f32x2 gg = *(const f32x2*)(lg + 2 * cp), bb = *(const f32x2*)(lb + 2 * cp);
#pragma unroll
        for (int k = 0; k < 8; ++k) {
            const float mean = tot[k] * (1.0f / 512.0f), var = tot[8 + k] * (1.0f / 512.0f) - mean * mean;
            const float rstd = __builtin_amdgcn_rsqf(fmaxf(var, 0.f) + EPS);
            f32x2 y = (h[k] - mean) * rstd * gg + bb;
            y.x = y.x * sigmoid_f(y.x); y.y = y.y * sigmoid_f(y.y);
            op[(size_t)k * 512] = cvtpk(y.x, y.y);
        }
    }
}
__device__ __forceinline__ void conv_units(LAS unsigned char* lds, const bf16_t* UB, const bf16_t* SCB_l, bf16_t* MIX, const float* cw, const float* cb, const float* lg, const float* lb, const int tid, const int bid, const int G) {
    f32x2 w[31];
#pragma unroll
    for (int j = 0; j < 31; ++j) w[j] = *(const f32x2*)(cw + j * 512 + 2 * (tid & 255));
    u32x4 rg[8];
    int it = bid;
    if (it < 2112) conv_fetch(rg, UB, SCB_l, it, tid);
#pragma unroll 1
    for (; it < 2112; it += G) {
        __syncthreads();
#pragma unroll
        for (int j = 0; j < 8; ++j) { const int idx = tid + 512 * j; if (idx < 62 * 64) *(LAS u32x4*)(lds + CIN_OFF + (idx >> 6) * 1024 + (idx & 63) * 16) = rg[j]; }
        __syncthreads();
        if (it + G < 2112) conv_fetch(rg, UB, SCB_l, it + G, tid);
        conv_compute(lds, MIX, w, cb, lg, lb, it, tid);
    }
}

__device__ __forceinline__ int crow(int r, int h) { return (r & 3) + 8 * (r >> 2) + 4 * h; }
struct AttnRegs { u32x4 k[3], v[3]; bf16x8 q[4]; };
__device__ __forceinline__ size_t attn_rows(int unit, bool& smp, int& first, int& sb) {
    const int gc = unit >> 1; smp = gc >= 1024; first = 0; sb = 0; size_t qrow0;
    if (!smp) { const int b = gc >> 6, c = gc & 63; qrow0 = (size_t)b * 4096 + c * 64; first = c >= 2 ? 0 : 2 - c; } else { sb = gc - 1024; qrow0 = (size_t)MP + sb * 64; }
    return qrow0;
}
__device__ __forceinline__ void attn_fetch(AttnRegs& R, const bf16_t* QB, const bf16_t* KB, const bf16_t* VB, const bf16_t* CKB_l, const bf16_t* CVB_l, int unit, const int tid) {
    const int lane = tid & 63, wid = __builtin_amdgcn_readfirstlane(tid >> 6), r32 = lane & 31, hi = lane >> 5, kh = unit & 1;
    bool smp; int first, sb; const size_t qrow0 = attn_rows(unit, smp, first, sb);
    { const int kv = tid >> 3, dg = tid & 7;
#pragma unroll
        for (int j = 0; j < 3; ++j) { R.k[j] = (u32x4){0u, 0u, 0u, 0u}; if (j >= first) {
            const bf16_t* src = (smp && j < 2) ? CKB_l + ((size_t)sb * 128 + j * 64) * 128 : KB + (qrow0 + j * 64 - 128) * 128;
            R.k[j] = *(const u32x4*)(src + (size_t)kv * 128 + kh * 64 + dg * 8); } } }
    { const int kv = tid & 63, dg = wid;
#pragma unroll
        for (int j = 0; j < 3; ++j) { R.v[j] = (u32x4){0u, 0u, 0u, 0u}; if (j >= first) {
            const bf16_t* src = (smp && j < 2) ? CVB_l + ((size_t)sb * 128 + j * 64) * 128 : VB + (qrow0 + j * 64 - 128) * 128;
            R.v[j] = *(const u32x4*)(src + (size_t)kv * 128 + kh * 64 + dg * 8); } } }
    const int g = wid >> 1, qh = wid & 1, head = kh * 4 + g;
    const bf16_t* qp = QB + (qrow0 + qh * 32 + r32) * 512 + head * 64 + hi * 8;
#pragma unroll
    for (int d0 = 0; d0 < 4; ++d0) R.q[d0] = *(const bf16x8*)(qp + d0 * 16);
}
constexpr int KOFF = 0, KSTR = 144, VOFF = 192 * 144, VSTR = 400;
__device__ __forceinline__ void attn_stage(LAS unsigned char* lds, const AttnRegs& R, const int tid) {
    const int wid = __builtin_amdgcn_readfirstlane(tid >> 6);
    { const int kv = tid >> 3, dg = tid & 7;
#pragma unroll
        for (int j = 0; j < 3; ++j) *(LAS u32x4*)(lds + KOFF + (j * 64 + kv) * KSTR + dg * 16) = R.k[j]; }
    { const int kv = tid & 63, dg = wid;
#pragma unroll
        for (int j = 0; j < 3; ++j) { const u32x4 v = R.v[j];
            const int w = j * 64 + kv, slot = (w & ~12) | ((w & 4) << 1) | ((w & 8) >> 1);
            LAS unsigned short* dst = (LAS unsigned short*)(lds + VOFF + (dg * 8) * VSTR + slot * 2);
#pragma unroll
            for (int i = 0; i < 8; ++i) dst[i * (VSTR / 2)] = (unsigned short)(v[i >> 1] >> (16 * (i & 1))); } }
}
__device__ __forceinline__ void attn_compute(LAS unsigned char* lds, const bf16x8 (&qf)[4], bf16_t* MIX, const float* sink_l, int unit, const int tid) {
    const int lane = tid & 63, wid = __builtin_amdgcn_readfirstlane(tid >> 6), r32 = lane & 31, hi = lane >> 5, kh = unit & 1;
    bool smp; int first, sb; const size_t qrow0 = attn_rows(unit, smp, first, sb);
    const int g = wid >> 1, qh = wid & 1, head = kh * 4 + g;
    const float sk = sink_l[head] * LOG2E;
    f32x16 p[6];
#pragma unroll
    for (int kt = 0; kt < 6; ++kt) {
        if ((kt >> 1) >= first) {
            f32x16 acc;
#pragma unroll
            for (int i = 0; i < 16; ++i) acc[i] = 0.f;
#pragma unroll
            for (int d0 = 0; d0 < 4; ++d0) { const bf16x8 kf = *(const LAS bf16x8*)(lds + KOFF + (kt * 32 + r32) * KSTR + (d0 * 16 + hi * 8) * 2);
                acc = __builtin_amdgcn_mfma_f32_32x32x16_bf16(kf, qf[d0], acc, 0, 0, 0); }
            p[kt] = acc;
        } else {
#pragma unroll
            for (int i = 0; i < 16; ++i) p[kt][i] = -1e30f;
        }
    }
    float mx = sk;
#pragma unroll
    for (int kt = 0; kt < 6; ++kt)
#pragma unroll
        for (int i = 0; i < 16; ++i) mx = fmaxf(mx, p[kt][i]);
    mx = fmaxf(mx, __shfl_xor(mx, 32));
    float sum = 0.f;
#pragma unroll
    for (int kt = 0; kt < 6; ++kt)
#pragma unroll
        for (int i = 0; i < 16; ++i) { const float e = __builtin_amdgcn_exp2f(p[kt][i] - mx); p[kt][i] = e; sum += e; }
    sum += __shfl_xor(sum, 32);
    const float inv = 1.0f / (sum + __builtin_amdgcn_exp2f(sk - mx));
    f32x16 o0, o1;
#pragma unroll
    for (int i = 0; i < 16; ++i) { o0[i] = 0.f; o1[i] = 0.f; }
#pragma unroll
    for (int kt = 0; kt < 6; ++kt) if ((kt >> 1) >= first) {
#pragma unroll
        for (int s = 0; s < 2; ++s) {
            u32x4 pw; pw.x = cvtpk(p[kt][8 * s] * inv, p[kt][8 * s + 1] * inv); pw.y = cvtpk(p[kt][8 * s + 2] * inv, p[kt][8 * s + 3] * inv);
            pw.z = cvtpk(p[kt][8 * s + 4] * inv, p[kt][8 * s + 5] * inv); pw.w = cvtpk(p[kt][8 * s + 6] * inv, p[kt][8 * s + 7] * inv);
            const bf16x8 pa = __builtin_bit_cast(bf16x8, pw);
            const bf16x8 v0 = *(const LAS bf16x8*)(lds + VOFF + r32 * VSTR + (kt * 32 + s * 16 + hi * 8) * 2);
            const bf16x8 v1 = *(const LAS bf16x8*)(lds + VOFF + (32 + r32) * VSTR + (kt * 32 + s * 16 + hi * 8) * 2);
            o0 = __builtin_amdgcn_mfma_f32_32x32x16_bf16(pa, v0, o0, 0, 0, 0);
            o1 = __builtin_amdgcn_mfma_f32_32x32x16_bf16(pa, v1, o1, 0, 0, 0);
        }
    }
    bf16_t* op = MIX + (qrow0 + qh * 32) * 1024 + head * 64 + r32;
#pragma unroll
    for (int i = 0; i < 16; ++i) { const int q = crow(i, hi);
        op[(size_t)q * 1024] = (bf16_t)(cvtpk(o0[i], 0.f) & 0xffffu); op[(size_t)q * 1024 + 32] = (bf16_t)(cvtpk(o1[i], 0.f) & 0xffffu); }
}
__device__ __forceinline__ void attn_units(LAS unsigned char* lds, const bf16_t* QB, const bf16_t* KB, const bf16_t* VB, const bf16_t* CKB_l, const bf16_t* CVB_l, bf16_t* MIX, const float* sink_l, const int tid, const int bid, const int G) {
    AttnRegs R;
    int it = G - 1 - bid;
    if (it < 2112) attn_fetch(R, QB, KB, VB, CKB_l, CVB_l, it, tid);
#pragma unroll 1
    for (; it < 2112; it += G) {
        __syncthreads();
        attn_stage(lds, R, tid);
        bf16x8 qf[4];
#pragma unroll
        for (int d0 = 0; d0 < 4; ++d0) qf[d0] = R.q[d0];
        __syncthreads();
        if (it + G < 2112) attn_fetch(R, QB, KB, VB, CKB_l, CVB_l, it + G, tid);
        attn_compute(lds, qf, MIX, sink_l, it, tid);
    }
}

__device__ __forceinline__ void combine_sample_rows(unsigned char* ws, int ssw, const int tid, const int bid, const int G) {
    const int lane = tid & 63, wave = tid >> 6, gw = bid * 8 + wave, NGW = G * 8;
    const float* part = (const float*)(ws + WS_PART); bf16_t* XB = (bf16_t*)(ws + WS_XB); float* SS = (float*)(ws + WS_SS) + (size_t)ssw * M;
    for (int r = gw; r < MS; r += NGW) {
        const int row = MP + r; u32x2* o8 = (u32x2*)(XB + (size_t)row * DM) + lane;
        f32x4 v[4];
#pragma unroll
        for (int j = 0; j < 4; ++j) { const u32x2 x = o8[64 * j]; v[j] = (f32x4){bf_lo(x.x), bf_hi(x.x), bf_lo(x.y), bf_hi(x.y)}; }
#pragma unroll
        for (int kz = 0; kz < 8; ++kz) { const f32x4* pp = (const f32x4*)(part + ((size_t)kz * MS + r) * DM) + lane;
#pragma unroll
            for (int j = 0; j < 4; ++j) v[j] += pp[64 * j]; }
        float sq = 0.f;
#pragma unroll
        for (int j = 0; j < 4; ++j) { u32x2 w; w.x = cvtpk(v[j][0], v[j][1]); w.y = cvtpk(v[j][2], v[j][3]); o8[64 * j] = w;
            sq += (v[j][0] * v[j][0] + v[j][1] * v[j][1]) + (v[j][2] * v[j][2] + v[j][3] * v[j][3]); }
        sq = wave_sum(sq);
        if (lane == 0) SS[row] = sq;
    }
}

constexpr int N_PHASES = 14, PPL = 6;
#ifndef MK_PER_PHASE
#define MK_PER_PHASE 0
#endif
#ifndef PROBE_REPEAT_PH
#define PROBE_REPEAT_PH 0
#define PROBE_NREP 0
#endif
#ifndef PROBE_NOEPI
#define PROBE_NOEPI 0
#endif

__device__ __forceinline__ void phase_gemm(LAS unsigned char* lds, unsigned char* ws, float* out, int l, int k, const int tid, const int bid, const int G, const bool noepi = false) {
    const int npass = (k == 4) ? 2 : 1;
#pragma unroll 1
    for (int pass = 0; pass < npass; ++pass) {
        pg8::Gemm g; g.M = M; g.ablk = 0; EpiAll E; E.ssr = 0; E.ssw = 0; E.layer = l; E.ws = ws; E.out = out;
        pg8::StaticOrder S; int rows = M; S.mode = 0;
        if (k == 0)      { g.A = (const bf16_t*)(ws + WS_XB);  g.Bt = (const bf16_t*)(ws + WS_WIN) + (size_t)l * NIN * DM; g.N = NIN; g.K = DM; g.KL = DM; E.kind = 0; E.ssr = 2 * l; }
        else if (k == 2) { g.A = (const bf16_t*)(ws + WS_MIX); g.Bt = (const bf16_t*)(ws + WS_WOUT) + (size_t)l * DM * DM; g.N = DM; g.K = DM; g.KL = DM; E.kind = 1; E.ssw = 2 * l + 1; }
        else if (k == 3) { g.A = (const bf16_t*)(ws + WS_XB);  g.Bt = (const bf16_t*)(ws + WS_WUP) + (size_t)l * FF * DM; g.N = FF; g.K = DM; g.KL = DM; E.kind = 2; E.ssr = 2 * l + 1; }
        else             { g.A = (const bf16_t*)(ws + WS_H);   g.Bt = (const bf16_t*)(ws + WS_WDN) + (size_t)l * DM * FF; g.N = DM; g.K = FF; E.ssw = 2 * l + 2;
                           if (pass == 0) { g.KL = FF; E.kind = 1; rows = MP; }
                           else           { g.KL = FF / 8; E.kind = 3; S.mode = 1; } }
        if (noepi) E.kind = 4;
        S.init(rows, g.N, G, bid);
        pg8::gemm_phase<EpiAll, pg8::StaticOrder, true, true>(lds, g, S, E, tid);
    }
}
__device__ __forceinline__ void phase_mixer(LAS unsigned char* lds, unsigned char* ws, const float* cw, const float* cb, const float* lg, const float* lb, const float* sink, int l, const int tid, const int bid, const int G) {
    bf16_t* QB = (bf16_t*)(ws + WS_Q); bf16_t* KB = (bf16_t*)(ws + WS_K); bf16_t* VB = (bf16_t*)(ws + WS_V); bf16_t* UB = (bf16_t*)(ws + WS_U); bf16_t* MIX = (bf16_t*)(ws + WS_MIX);
    const bf16_t* SCB_l = (const bf16_t*)(ws + WS_SC) + (size_t)l * 32 * 30 * 512;
    const bf16_t* CKB_l = (const bf16_t*)(ws + WS_CK) + (size_t)l * 32 * 128 * 128; const bf16_t* CVB_l = (const bf16_t*)(ws + WS_CV) + (size_t)l * 32 * 128 * 128;
    conv_units(lds, UB, SCB_l, MIX, cw + l * 31 * 512, cb + l * 512, lg + l * 512, lb + l * 512, tid, bid, G);
    attn_units(lds, QB, KB, VB, CKB_l, CVB_l, MIX, sink + l * 8, tid, bid, G);
    __syncthreads();
}
__device__ __forceinline__ void final_row(const float* SS, const bf16_t* XB, const float* part, float* out, const float* fn, int m, int lane) {
    f32x4* p = (f32x4*)(out + (size_t)m * DM) + lane; const f32x4* gp = (const f32x4*)fn + lane; const u32x2* xp = (const u32x2*)(XB + (size_t)m * DM) + lane;
    f32x4 v[4];
#pragma unroll
    for (int j = 0; j < 4; ++j) { const u32x2 x = xp[64 * j]; v[j] = (f32x4){bf_lo(x.x), bf_hi(x.x), bf_lo(x.y), bf_hi(x.y)}; }
    float rs;
    if (m < MP) rs = row_rstd(SS, m);
    else {
        const int r = m - MP;
#pragma unroll
        for (int kz = 0; kz < 8; ++kz) { const f32x4* pp = (const f32x4*)(part + ((size_t)kz * MS + r) * DM) + lane;
#pragma unroll
            for (int j = 0; j < 4; ++j) v[j] += pp[64 * j]; }
        float sq = 0.f;
#pragma unroll
        for (int j = 0; j < 4; ++j) sq += (v[j][0] * v[j][0] + v[j][1] * v[j][1]) + (v[j][2] * v[j][2] + v[j][3] * v[j][3]);
        rs = __builtin_amdgcn_rsqf(wave_sum(sq) * (1.0f / 1024.0f) + EPS);
    }
#pragma unroll
    for (int j = 0; j < 4; ++j) p[64 * j] = v[j] * rs * gp[64 * j];
}
__device__ __forceinline__ void phase_final(unsigned char* ws, float* out, const float* fn, const int tid, const int bid, const int G) {
    const float* SS = (const float*)(ws + WS_SS) + (size_t)4 * M; const bf16_t* XB = (const bf16_t*)(ws + WS_XB); const float* part = (const float*)(ws + WS_PART);
    const int lane = tid & 63, wave = tid >> 6, gw = bid * 8 + wave, NGW = G * 8;
    for (int m0 = gw; m0 < M; m0 += 4 * NGW) {
        if (m0 + 3 * NGW < MP) {
            u32x2 x[4][4]; float ss[4];
#pragma unroll
            for (int r = 0; r < 4; ++r) { const u32x2* xp = (const u32x2*)(XB + (size_t)(m0 + r * NGW) * DM) + lane;
#pragma unroll
                for (int j = 0; j < 4; ++j) x[r][j] = xp[64 * j];
                ss[r] = SS[m0 + r * NGW]; }
            f32x4 g4[4];
#pragma unroll
            for (int j = 0; j < 4; ++j) g4[j] = ((const f32x4*)fn + lane)[64 * j];
#pragma unroll
            for (int r = 0; r < 4; ++r) { const float rs = __builtin_amdgcn_rsqf(ss[r] * (1.0f / 1024.0f) + EPS); f32x4* p = (f32x4*)(out + (size_t)(m0 + r * NGW) * DM) + lane;
#pragma unroll
                for (int j = 0; j < 4; ++j) { const f32x4 v = {bf_lo(x[r][j].x), bf_hi(x[r][j].x), bf_lo(x[r][j].y), bf_hi(x[r][j].y)}; p[64 * j] = v * rs * g4[j]; } }
        } else {
            for (int r = 0; r < 4; ++r) { const int m = m0 + r * NGW; if (m < M) final_row(SS, XB, part, out, fn, m, lane); }
        }
    }
}

#if MK_PER_PHASE
template <int KIND> __global__ void __launch_bounds__(512, 2) phase_kernel(Args a, int ph) {
    extern __shared__ __attribute__((aligned(16))) unsigned char lds_raw[];
    LAS unsigned char* lds = (LAS unsigned char*)lds_raw;
    unsigned char* ws = a.ws; float* out = a.out;
    const int G = gridDim.x, tid = threadIdx.x, bid = blockIdx.x;
    const bool noepi = ph >= 100; if (noepi) ph -= 100;
    const int l = (ph - 1) / PPL, k = (ph - 1) % PPL;
    if constexpr (KIND == 0) prologue(lds, a, tid, bid);
    else if constexpr (KIND == 3) phase_final(ws, out, a.in[I_FN], tid, bid, G);
    else if constexpr (KIND == 4) combine_sample_rows(ws, 2 * l + 2, tid, bid, G);
    else if constexpr (KIND == 2) phase_mixer(lds, ws, a.in[I_CW], a.in[I_CB], a.in[I_LG], a.in[I_LB], a.in[I_SINK], l, tid, bid, G);
    else phase_gemm(lds, ws, out, l, k, tid, bid, G, noepi);
}
#else
__global__ void __launch_bounds__(512, 2) fwd_megakernel(Args a_unused) {
    extern __shared__ __attribute__((aligned(16))) unsigned char lds_raw[];
    LAS unsigned char* lds = (LAS unsigned char*)lds_raw;
    cg::grid_group grid = cg::this_grid();
    const Args* ap0 = (const Args*)__builtin_amdgcn_kernarg_segment_ptr();
    const int ph_lo = ap0->ph_lo, ph_hi = ap0->ph_hi;
    if (threadIdx.x < 64) ((LAS unsigned*)(lds + MISC_OFF))[threadIdx.x] = 0u;
    __syncthreads();
    const int wave_id = __builtin_amdgcn_readfirstlane((int)(threadIdx.x >> 6));
    const XcdBarrier xbar = xcd_barrier_post((unsigned*)(ap0->ws + WS_CTL) + BAR_WORD0, (volatile LAS unsigned*)(lds + MISC_OFF));
#pragma unroll 1
    for (int ph = ph_lo; ph < ph_hi; ++ph) {
        const Args* ap = (const Args*)__builtin_amdgcn_kernarg_segment_ptr(); asm volatile("" : "+s"(ap));
        unsigned char* ws = opaque_uniform(ap->ws); float* out = opaque_uniform(ap->out);
        const int G = gridDim.x;
        int tid = wave_id * 64 + (int)__builtin_amdgcn_mbcnt_hi(~0u, __builtin_amdgcn_mbcnt_lo(~0u, 0u)), bid = blockIdx.x;
        asm volatile("" : "+v"(tid)); asm volatile("" : "+s"(bid)); tid &= 511; bid &= 1023;
        const int l = (ph - 1) / PPL, k = (ph - 1) % PPL;
        if (ph == N_PHASES - 2) continue;
        if (ph == 0) {
            Args a;
#pragma unroll
            for (int i = 0; i < 17; ++i) a.in[i] = ap->in[i];
            a.out = out; a.ws = ws; a.ph_lo = 0; a.ph_hi = 0;
            prologue(lds, a, tid, bid);
        } else if (ph == N_PHASES - 1) phase_final(ws, out, opaque_uniform(ap->in[I_FN]), tid, bid, G);
        else if (k == 1) phase_mixer(lds, ws, opaque_uniform(ap->in[I_CW]), opaque_uniform(ap->in[I_CB]), opaque_uniform(ap->in[I_LG]), opaque_uniform(ap->in[I_LB]), opaque_uniform(ap->in[I_SINK]), l, tid, bid, G);
        else if (k == 5) combine_sample_rows(ws, 2 * l + 2, tid, bid, G);
        else phase_gemm(lds, ws, out, l, k, tid, bid, G);
        if (ph + 1 < ph_hi) { XcdBarrier b = xbar; asm volatile("" : "+s"(b.x)); xcd_barrier(b);
            if (ph == ph_lo && xb_ld(&b.bar[XB_TMO]) != 0u) grid.sync(); }
    }
}
#endif

extern "C" void kernel_launch(void* const* d_in, const int* in_sizes, int n_in, void* d_out, int out_size, void* d_ws, size_t ws_size, hipStream_t stream) {
    static int grid = 0;
    if (grid == 0) {
        if (n_in != 17 || (size_t)out_size != O_END || ws_size < WS_END) { fprintf(stderr, "kernel_launch: unexpected shapes: n_in %d out %d ws %zu (need %zu)\n", n_in, out_size, ws_size, (size_t)WS_END); grid = -1; return; }
        int dev = 0, cus = 0, per_cu = 0;
        if (hipGetDevice(&dev) != hipSuccess || hipDeviceGetAttribute(&cus, hipDeviceAttributeMultiprocessorCount, dev) != hipSuccess) { grid = -1; return; }
#if MK_PER_PHASE
        if (hipFuncSetAttribute((const void*)phase_kernel<0>, hipFuncAttributeMaxDynamicSharedMemorySize, LDS_BYTES) != hipSuccess || hipFuncSetAttribute((const void*)phase_kernel<1>, hipFuncAttributeMaxDynamicSharedMemorySize, LDS_BYTES) != hipSuccess ||
            hipFuncSetAttribute((const void*)phase_kernel<2>, hipFuncAttributeMaxDynamicSharedMemorySize, LDS_BYTES) != hipSuccess || hipFuncSetAttribute((const void*)phase_kernel<3>, hipFuncAttributeMaxDynamicSharedMemorySize, LDS_BYTES) != hipSuccess ||
            hipFuncSetAttribute((const void*)phase_kernel<4>, hipFuncAttributeMaxDynamicSharedMemorySize, LDS_BYTES) != hipSuccess) { fprintf(stderr, "kernel_launch: hipFuncSetAttribute failed\n"); grid = -1; return; }
        (void)per_cu;
#else
        if (hipFuncSetAttribute((const void*)fwd_megakernel, hipFuncAttributeMaxDynamicSharedMemorySize, LDS_BYTES) != hipSuccess) { fprintf(stderr, "kernel_launch: hipFuncSetAttribute failed\n"); grid = -1; return; }
        if (hipOccupancyMaxActiveBlocksPerMultiprocessor(&per_cu, (const void*)fwd_megakernel, 512, LDS_BYTES) != hipSuccess || per_cu < 1) { fprintf(stderr, "kernel_launch: occupancy query says %d\n", per_cu); per_cu = 1; }
#endif
        (void)hipGetLastError();
        grid = cus;
    }
    if (grid < 0) return;
    Args a{};
    for (int i = 0; i < 17; ++i) a.in[i] = (const float*)d_in[i];
    a.out = (float*)d_out; a.ws = (unsigned char*)d_ws;
#if MK_PER_PHASE
    for (int ph0 = 0; ph0 < N_PHASES + PROBE_NREP; ++ph0) {
        const int ph = ph0 <= PROBE_REPEAT_PH ? ph0 : (ph0 <= PROBE_REPEAT_PH + PROBE_NREP ? PROBE_REPEAT_PH : ph0 - PROBE_NREP);
        const int k = (ph - 1) % PPL;
        if (ph == N_PHASES - 2) continue;
        if (ph == 0) hipLaunchKernelGGL(phase_kernel<0>, dim3(grid), dim3(512), LDS_BYTES, stream, a, ph);
        else if (ph == N_PHASES - 1) hipLaunchKernelGGL(phase_kernel<3>, dim3(grid), dim3(512), LDS_BYTES, stream, a, ph);
        else if (k == 1) hipLaunchKernelGGL(phase_kernel<2>, dim3(grid), dim3(512), LDS_BYTES, stream, a, ph);
        else if (k == 5) hipLaunchKernelGGL(phase_kernel<4>, dim3(grid), dim3(512), LDS_BYTES, stream, a, ph);
        else hipLaunchKernelGGL(phase_kernel<1>, dim3(grid), dim3(512), LDS_BYTES, stream, a, (PROBE_NOEPI && ph0 > PROBE_REPEAT_PH && ph0 <= PROBE_REPEAT_PH + PROBE_NREP) ? ph + 100 : ph);
    }
#else
    a.ph_lo = 0; a.ph_hi = N_PHASES;
    if (hipMemsetAsync((char*)d_ws + WS_CTL, 0, CTL_ZERO_BYTES, stream) != hipSuccess) { fprintf(stderr, "kernel_launch: hipMemsetAsync failed\n"); return; }
    void* kargs[] = {&a};
    const hipError_t e = hipLaunchCooperativeKernel((const void*)fwd_megakernel, dim3(grid), dim3(512), kargs, LDS_BYTES, stream);
    if (e != hipSuccess) fprintf(stderr, "kernel_launch: cooperative launch failed: %s (grid %d)\n", hipGetErrorString(e), grid);
#endif
}
```

```cpp
#include <hip/hip_runtime.h>
#include <hip/hip_cooperative_groups.h>
#include <cstdio>
#include <cstdint>
namespace cg = cooperative_groups;
namespace pg8 {
#define PG8_LAS __attribute__((address_space(3)))
typedef unsigned short bf16_t;
typedef short bf16x8 __attribute__((ext_vector_type(8)));
typedef float f32x4 __attribute__((ext_vector_type(4)));
typedef unsigned u32x4 __attribute__((ext_vector_type(4)));
constexpr int BM = 256, BK = 64, HALF = 128, HTB = HALF * BK * 2  , STAGE_BYTES = 8 * HTB, NXCD = 8, WGM = 8;

__host__ __device__ __forceinline__ int lds_byte(int r, int c) { const int st = (r >> 4) * 2 + (c >> 5), rr = r & 15, cc = c & 31, ob = rr * 64 + cc * 2; return st * 1024 + (ob ^ (((ob >> 9) & 1) << 5)); }
__host__ __device__ __forceinline__ void stage_rc(int b, int& R, int& C) { const int st = b / 1024, sb = b % 1024, swz = sb ^ (((sb >> 9) & 1) << 5); R = (st >> 1) * 16 + swz / 64; C = (st & 1) * 32 + (swz % 64) / 2; }
__host__ __device__ __forceinline__ int perm32(int rho) { const int n = rho >> 4, i = rho & 15; return 8 * (i >> 2) + 4 * n + (i & 3); }

struct Unit { int pm, pn, kz; };
struct Gemm { const bf16_t* A; const bf16_t* Bt; int M, N, K, KL, ablk; };

struct StaticOrder {
    int nM, nN, nwg, G, c;
    __host__ __device__ void init(int M, int N, int G_, int c_) { nM = M / BM; nN = N / BM; nwg = nM * nN; G = G_; c = c_; }
    __host__ __device__ bool next(int i, Unit& u) const {
        const long L = (long)i * G + c; if (L >= nwg) return false;
        int wgid = (int)L; { const int q = nwg / NXCD, r = nwg % NXCD, xcd = wgid % NXCD, off = wgid / NXCD; wgid = (xcd < r ? xcd * (q + 1) : r * (q + 1) + (xcd - r) * q) + off; }
        const int wgm = nN >= 7 ? 4 : WGM;
        const int nig = wgm * nN, gid = wgid / nig, fm = gid * wgm, gsz = (nM - fm) < wgm ? (nM - fm) : wgm;
        u.pm = fm + ((wgid % nig) % gsz); u.pn = (wgid % nig) / gsz; u.kz = 0; return true;
    }
    int mode;
    __host__ __device__ bool next_any(int i, Unit& u) const {
        if (mode == 0) return next(i, u);
        const int p = i * G + c; if (p >= 256) return false;
        u.kz = p & 7; const int t = p >> 3; u.pm = 256 + (t >> 2); u.pn = t & 3; return true;
    }
    __device__ __forceinline__ void a_ready(const Unit&) const {}
    __device__ __forceinline__ void done(const Unit&) const {}
};

__device__ __forceinline__ unsigned cvt_pk_bf16(float lo, float hi) { unsigned r; asm volatile("v_cvt_pk_bf16_f32 %0, %1, %2" : "=v"(r) : "v"(lo), "v"(hi)); return r; }
template <class Epi, class Sched, bool ALIGN_EPI = false, bool SP2 = false>
__device__ __forceinline__ void gemm_phase(PG8_LAS unsigned char* lds, const Gemm g, const Sched& S, const Epi& E, const int tid_in) {
    const int tid = tid_in, wid = __builtin_amdgcn_readfirstlane(tid >> 6), lane = tid & 63, wr = wid >> 2, wc = wid & 3, fr = lane & 15, fq = lane >> 4;
    const int K = g.K, nt = g.KL / BK;
    const int pitchA = g.ablk ? BK : K;
    unsigned voffA[2], voffB[2];
#pragma unroll
    for (int i = 0; i < 2; ++i) { int R, C; stage_rc(tid * 16 + i * 8192, R, C); const int Rb = Epi::PERM ? ((R >> 5) * 64 + perm32(R & 31)) : R;
        voffA[i] = (unsigned)(R * pitchA + C) * 2u; voffB[i] = (unsigned)(Rb * K + C) * 2u; }
    const size_t kstep = (size_t)(BK * 2);
    const size_t hstep = (size_t)HALF * K * 2;
    const size_t tstep = 2 * hstep;
    const size_t hstepB = Epi::PERM ? (size_t)32 * K * 2 : hstep;
    const size_t kstepA = g.ablk ? (size_t)(BM * BK * 2) : kstep, hstepA = g.ablk ? (size_t)(HALF * BK * 2) : hstep, tstepA = g.ablk ? (size_t)(K / BK) * (size_t)(BM * BK * 2) : tstep;
    const unsigned ldsw = (unsigned)wid * 1024u;
    const int aoff = lds_byte(wr * 64 + fr, fq * 8), boff = lds_byte(wc * 32 + fr, fq * 8);
#define PG8_SA(b, h) (((b) * 2 + (h)) * HTB)
#define PG8_SB(b, h) ((4 + (b) * 2 + (h)) * HTB)
#define PG8_STAGE(bufoff, gbase, voff) do { _Pragma("unroll") for (int _i = 0; _i < 2; ++_i) \
        __builtin_amdgcn_global_load_lds((const unsigned*)((const char*)(gbase) + (voff)[_i]), (PG8_LAS unsigned*)(lds + (bufoff) + ldsw + _i * 8192), 16, 0, 0); } while (0)
#define PG8_LDA(dst, b, h) do { _Pragma("unroll") for (int m = 0; m < 4; ++m) _Pragma("unroll") for (int k = 0; k < 2; ++k) dst[m][k] = *(const PG8_LAS bf16x8*)(lds + PG8_SA(b, h) + aoff + m * 2048 + k * 1024); } while (0)
#define PG8_LDB(dst, b, h) do { _Pragma("unroll") for (int n = 0; n < 2; ++n) _Pragma("unroll") for (int k = 0; k < 2; ++k) dst[n][k] = *(const PG8_LAS bf16x8*)(lds + PG8_SB(b, h) + boff + n * 2048 + k * 1024); } while (0)
#define PG8_MMA(ai, bj, At, Bt) do { __builtin_amdgcn_s_setprio(1); _Pragma("unroll") for (int m = 0; m < 4; ++m) _Pragma("unroll") for (int n = 0; n < 2; ++n) _Pragma("unroll") for (int k = 0; k < 2; ++k) \
        acc[ai][bj][m][n] = __builtin_amdgcn_mfma_f32_16x16x32_bf16(Bt[n][k], At[m][k], acc[ai][bj][m][n], 0, 0, 0); __builtin_amdgcn_s_setprio(0); } while (0)
#define PG8_WAIT_V(n) asm volatile("s_waitcnt vmcnt(" #n ")" ::: "memory")
#define PG8_WAIT_L(n) asm volatile("s_waitcnt lgkmcnt(" #n ")" ::: "memory")
#define PG8_BAR __builtin_amdgcn_s_barrier()
#define PG8_SCHED __builtin_amdgcn_sched_barrier(0)
    Unit cur, nxt; int ui = 0;
    if (!S.next_any(0, cur)) return;
    f32x4 acc[2][2][4][2];
#pragma unroll
    for (int a = 0; a < 2; ++a)
#pragma unroll
        for (int b = 0; b < 2; ++b)
#pragma unroll
            for (int m = 0; m < 4; ++m)
#pragma unroll
                for (int n = 0; n < 2; ++n) acc[a][b][m][n] = (f32x4){0.f, 0.f, 0.f, 0.f};
    bf16x8 At[4][2], B0[2][2], B1[2][2];
    const char* cA = (const char*)g.A + (size_t)cur.pm * tstepA + (size_t)cur.kz * nt * kstepA; const char* cB = (const char*)g.Bt + (size_t)cur.pn * tstep + (size_t)cur.kz * g.KL * 2;
    S.a_ready(cur);
    if constexpr (SP2) {
        PG8_STAGE(PG8_SB(0, 0), cB, voffB); PG8_STAGE(PG8_SB(0, 1), cB + hstepB, voffB); PG8_STAGE(PG8_SA(0, 0), cA, voffA); PG8_STAGE(PG8_SA(0, 1), cA + hstepA, voffA);
        if (wr == 1) PG8_BAR;
        PG8_WAIT_V(2); PG8_BAR;
        PG8_STAGE(PG8_SB(1, 0), cB + kstep, voffB); PG8_STAGE(PG8_SA(1, 0), cA + kstepA, voffA); PG8_STAGE(PG8_SB(1, 1), cB + hstepB + kstep, voffB);
        PG8_WAIT_V(6); PG8_BAR;
    } else {
        PG8_STAGE(PG8_SB(0, 0), cB, voffB); PG8_STAGE(PG8_SA(0, 0), cA, voffA); PG8_STAGE(PG8_SB(0, 1), cB + hstepB, voffB); PG8_STAGE(PG8_SA(0, 1), cA + hstepA, voffA);
        if (wr == 1) PG8_BAR;
        PG8_WAIT_V(4); PG8_BAR;
        PG8_STAGE(PG8_SB(1, 0), cB + kstep, voffB); PG8_STAGE(PG8_SA(1, 0), cA + kstepA, voffA); PG8_STAGE(PG8_SB(1, 1), cB + hstepB + kstep, voffB);
        PG8_WAIT_V(6); PG8_BAR;
    }
    for (;;) {
        const bool has_next = S.next_any(ui + 1, nxt);
        const char* nA = has_next ? (const char*)g.A + (size_t)nxt.pm * tstepA + (size_t)nxt.kz * nt * kstepA : cA; const char* nB = has_next ? (const char*)g.Bt + (size_t)nxt.pn * tstep + (size_t)nxt.kz * g.KL * 2 : cB;
        for (int t = 0; t < nt; t += 2) {
            const bool last = (t == nt - 2);
            const char* a1 = cA + (size_t)(t + 1) * kstepA;
            const char* a2 = last ? nA : cA + (size_t)(t + 2) * kstepA; const char* b2 = last ? nB : cB + (size_t)(t + 2) * kstep;
            const char* a3 = a2 + kstepA; const char* b3 = b2 + kstep;
            if (last && has_next) S.a_ready(nxt);
            if constexpr (SP2) {
            PG8_LDB(B0, 0, 0); PG8_LDB(B1, 0, 1); PG8_SCHED; PG8_LDA(At, 0, 0); PG8_STAGE(PG8_SA(1, 1), a1 + hstepA, voffA);
            PG8_WAIT_V(8); PG8_WAIT_L(0); PG8_BAR; PG8_MMA(0, 0, At, B0); PG8_MMA(0, 1, At, B1); PG8_BAR; PG8_SCHED;
            PG8_LDA(At, 0, 1); PG8_STAGE(PG8_SB(0, 0), b2, voffB); PG8_STAGE(PG8_SB(0, 1), b2 + hstepB, voffB); PG8_STAGE(PG8_SA(0, 0), a2, voffA);
            PG8_WAIT_V(8); PG8_WAIT_L(0); PG8_BAR; PG8_MMA(1, 0, At, B0); PG8_MMA(1, 1, At, B1); PG8_BAR; PG8_SCHED;
            PG8_LDB(B0, 1, 0); PG8_LDB(B1, 1, 1); PG8_SCHED; PG8_LDA(At, 1, 0); PG8_STAGE(PG8_SA(0, 1), a2 + hstepA, voffA);
            PG8_WAIT_V(8); PG8_WAIT_L(0); PG8_BAR; PG8_MMA(0, 0, At, B0); PG8_MMA(0, 1, At, B1); PG8_BAR; PG8_SCHED;
            PG8_LDA(At, 1, 1); PG8_STAGE(PG8_SB(1, 0), b3, voffB); PG8_STAGE(PG8_SB(1, 1), b3 + hstepB, voffB); PG8_STAGE(PG8_SA(1, 0), a3, voffA);
            PG8_WAIT_V(8); PG8_WAIT_L(0); PG8_BAR; PG8_MMA(1, 0, At, B0); PG8_MMA(1, 1, At, B1); PG8_BAR; PG8_SCHED;
            } else {
            PG8_LDB(B0, 0, 0); PG8_SCHED; PG8_LDA(At, 0, 0); PG8_STAGE(PG8_SA(1, 1), a1 + hstepA, voffA);
            PG8_WAIT_L(8); PG8_BAR; PG8_WAIT_L(0); PG8_MMA(0, 0, At, B0); PG8_BAR; PG8_SCHED;
            PG8_LDB(B1, 0, 1); PG8_STAGE(PG8_SB(0, 0), b2, voffB);
            PG8_BAR; PG8_WAIT_L(0); PG8_MMA(0, 1, At, B1); PG8_BAR;
            PG8_LDA(At, 0, 1); PG8_STAGE(PG8_SA(0, 0), a2, voffA);
            PG8_BAR; PG8_WAIT_L(0); PG8_MMA(1, 0, At, B0); PG8_BAR; PG8_SCHED;
            PG8_STAGE(PG8_SB(0, 1), b2 + hstepB, voffB);
            PG8_WAIT_V(6); PG8_BAR; PG8_MMA(1, 1, At, B1); PG8_BAR;
            PG8_LDB(B0, 1, 0); PG8_SCHED; PG8_LDA(At, 1, 0); PG8_STAGE(PG8_SA(0, 1), a2 + hstepA, voffA);
            PG8_WAIT_L(8); PG8_BAR; PG8_WAIT_L(0); PG8_MMA(0, 0, At, B0); PG8_BAR; PG8_SCHED;
            PG8_LDB(B1, 1, 1); PG8_STAGE(PG8_SB(1, 0), b3, voffB);
            PG8_BAR; PG8_WAIT_L(0); PG8_MMA(0, 1, At, B1); PG8_BAR;
            PG8_LDA(At, 1, 1); PG8_STAGE(PG8_SA(1, 0), a3, voffA);
            PG8_BAR; PG8_WAIT_L(0); PG8_MMA(1, 0, At, B0); PG8_BAR; PG8_SCHED;
            PG8_STAGE(PG8_SB(1, 1), b3 + hstepB, voffB);
            PG8_WAIT_V(6); PG8_BAR; PG8_MMA(1, 1, At, B1); PG8_BAR;
            }
        }
        if constexpr (ALIGN_EPI) { if (wr == 0) PG8_BAR; }
        if constexpr (!Epi::AFTER_DRAIN) { E(acc, cur, wr, wc, fr, fq); S.done(cur); }
        if (!has_next) break;
#pragma unroll
        for (int a = 0; a < 2; ++a)
#pragma unroll
            for (int b = 0; b < 2; ++b)
#pragma unroll
                for (int m = 0; m < 4; ++m)
#pragma unroll
                    for (int n = 0; n < 2; ++n) acc[a][b][m][n] = (f32x4){0.f, 0.f, 0.f, 0.f};
        cur = nxt; cA = nA; cB = nB; ++ui;
        if constexpr (ALIGN_EPI) { if (wr == 1) PG8_BAR; }
    }
    PG8_WAIT_V(0);
    if constexpr (!ALIGN_EPI) { if (wr == 0) PG8_BAR; }
    PG8_BAR;
    if constexpr (Epi::AFTER_DRAIN) { E.fused(acc, cur, wr, wc, fr, fq, lds, wid, lane); S.done(cur); }
#undef PG8_SA
#undef PG8_SB
#undef PG8_STAGE
#undef PG8_LDA
#undef PG8_LDB
#undef PG8_MMA
#undef PG8_WAIT_V
#undef PG8_WAIT_L
#undef PG8_BAR
#undef PG8_SCHED
}
}

#define LAS __attribute__((address_space(3)))
typedef unsigned short bf16_t;
typedef short bf16x8 __attribute__((ext_vector_type(8)));
typedef float f32x2 __attribute__((ext_vector_type(2)));
typedef float f32x4 __attribute__((ext_vector_type(4)));
typedef float f32x16 __attribute__((ext_vector_type(16)));
typedef unsigned u32x2 __attribute__((ext_vector_type(2)));
typedef unsigned u32x4 __attribute__((ext_vector_type(4)));
typedef __bf16 bf16x2_t __attribute__((ext_vector_type(2)));

constexpr int DM = 1024, MP = 65536, MS = 2048, M = MP + MS, NIN = 1792, FF = 4096;
constexpr float EPS = 1e-5f;
constexpr float LOG2E = 1.4426950408889634f;
constexpr float C2 = 0.125f * LOG2E;
constexpr size_t O_KP = (size_t)M * DM;
constexpr size_t O_VP = O_KP + 2 * 16 * 128 * 128;
constexpr size_t O_CP = O_VP + 2 * 16 * 128 * 128;
constexpr size_t O_KS = O_CP + 2 * 16 * 30 * 512;
constexpr size_t O_VS = O_KS + 2 * 32 * 128 * 128;
constexpr size_t O_CS = O_VS + 2 * 32 * 128 * 128;
constexpr size_t O_END = O_CS + 2 * 32 * 30 * 512;
constexpr size_t MiB = 1u << 20;
constexpr size_t WS_CTL = 0, WS_WIN = 1 * MiB, WS_WOUT = 8 * MiB, WS_WUP = 12 * MiB, WS_WDN = 28 * MiB, WS_SS = 44 * MiB, WS_CK = 49 * MiB, WS_CV = 51 * MiB, WS_SC = 53 * MiB;
constexpr size_t WS_XB = 56 * MiB, WS_H = 188 * MiB, WS_PART = 716 * MiB, WS_END = 780 * MiB;
constexpr size_t WS_Q = WS_H, WS_K = WS_H + 66 * MiB, WS_V = WS_K + 17 * MiB, WS_U = WS_V + 17 * MiB, WS_MIX = WS_U + 66 * MiB;
static_assert(WS_MIX + 132 * MiB <= WS_PART && WS_H + 528 * MiB <= WS_PART, "ws map");
constexpr int LDS_BYTES = 147456;

__device__ __forceinline__ unsigned cvtpk(float lo, float hi) { f32x2 v = {lo, hi}; bf16x2_t b = __builtin_convertvector(v, bf16x2_t); return __builtin_bit_cast(unsigned, b); }
__device__ __forceinline__ float bf_lo(unsigned u) { return __uint_as_float(u << 16); }
__device__ __forceinline__ float bf_hi(unsigned u) { return __uint_as_float(u & 0xffff0000u); }
__device__ __forceinline__ float wave_sum(float v) {
#pragma unroll
    for (int o = 1; o < 64; o <<= 1) v += __shfl_xor(v, o);
    return v;
}
__device__ __forceinline__ float row_rstd(const float* SS, int row) { return __builtin_amdgcn_rsqf(SS[row] * (1.0f / 1024.0f) + EPS); }
__device__ __forceinline__ float sigmoid_f(float x) { return __builtin_amdgcn_rcpf(1.0f + __builtin_amdgcn_exp2f(-LOG2E * x)); }

#define XB_TMO      128
#define XB_XCNT(j)  (256  + 64 * (j))
#define XB_XSUB(j)  (1280 + 64 * (j))
#define XB_XGEN(j)  (2304 + 64 * (j))
#define XB_TOP      3328
#define XB_TOPGEN   3392
#define XCD_BAR_WORDS 3456
#define XB_SPIN_CAP (1u << 18)

__device__ __forceinline__ unsigned xb_ld(unsigned* p)              { return __hip_atomic_load(p, __ATOMIC_RELAXED, __HIP_MEMORY_SCOPE_AGENT); }
__device__ __forceinline__ unsigned xb_add(unsigned* p, unsigned v) { return __hip_atomic_fetch_add(p, v, __ATOMIC_RELAXED, __HIP_MEMORY_SCOPE_AGENT); }
__device__ __forceinline__ unsigned xb_xcc_id() { return (unsigned)__builtin_amdgcn_s_getreg((3 << 11) | 20) & 0xFu; }
#define XB_SPIN(cond, bar) do { unsigned _sp = 0; while (cond) { __builtin_amdgcn_s_sleep(1); \
    if ((++_sp & 255u) == 0u) { if (xb_ld(&(bar)[XB_TMO])) break; if (_sp > XB_SPIN_CAP) { atomicAdd(&(bar)[XB_TMO], 1u); break; } } } } while (0)

struct XcdBarrier {
    unsigned* bar; unsigned x;
    volatile LAS unsigned* st;
};

__device__ __forceinline__ XcdBarrier xcd_barrier_post(unsigned* bar, volatile LAS unsigned* st) {
    XcdBarrier b; b.bar = bar; b.x = xb_xcc_id(); b.st = st;
    if (threadIdx.x == 0) (void)xb_add(&bar[XB_XCNT(b.x)], 1u);
    return b;
}
__device__ __forceinline__ void xcd_barrier_complete(unsigned* bar, unsigned x, unsigned& nloc, unsigned& nx) {
    const unsigned G = gridDim.x * gridDim.y * gridDim.z;
    unsigned sum, cnt, mine, sp = 0u;
    for (;;) {
        sum = 0u; cnt = 0u; mine = 0u;
#pragma unroll
        for (unsigned j = 0; j < 16; ++j) { const unsigned c = xb_ld(&bar[XB_XCNT(j)]); sum += c; cnt += (c > 0u) ? 1u : 0u; mine = (j == x) ? c : mine; }
        if (sum == G) break;
        __builtin_amdgcn_s_sleep(1);
        if ((++sp & 255u) == 0u) { if (xb_ld(&bar[XB_TMO])) break; if (sp > XB_SPIN_CAP) { atomicAdd(&bar[XB_TMO], 1u); break; } }
    }
    nloc = mine > 0u ? mine : 1u; nx = cnt > 0u ? cnt : 1u;
}

__device__ __forceinline__ void xcd_barrier(const XcdBarrier& b) {
    asm volatile("s_waitcnt vmcnt(0)" ::: "memory");
    __syncthreads();
    if (threadIdx.x == 0) {
        unsigned* bar = b.bar;
        __builtin_amdgcn_s_waitcnt(0);
        unsigned nloc = b.st[0], nx = b.st[1];
        if (nloc == 0u) { xcd_barrier_complete(bar, b.x, nloc, nx); b.st[0] = nloc; b.st[1] = nx; }
        const unsigned old = xb_add(&bar[XB_XSUB(b.x)], 1u);
        const unsigned gen = old / nloc;
        if (old + 1u == (gen + 1u) * nloc) {
            __builtin_amdgcn_fence(__ATOMIC_RELEASE, "agent");
            asm volatile("s_waitcnt vmcnt(0)" ::: "memory");
            const unsigned og = xb_add(&bar[XB_TOP], 1u);
            const unsigned tg = og / nx;
            if (og + 1u == (tg + 1u) * nx) xb_add(&bar[XB_TOPGEN], 1u);
            else XB_SPIN(xb_ld(&bar[XB_TOPGEN]) == tg, bar);
            __builtin_amdgcn_fence(__ATOMIC_ACQUIRE, "agent");
            xb_add(&bar[XB_XGEN(b.x)], 1u);
            asm volatile("s_waitcnt vmcnt(0)" ::: "memory");
        } else {
            XB_SPIN(xb_ld(&bar[XB_XGEN(b.x)]) == gen, bar);
            __builtin_amdgcn_fence(__ATOMIC_ACQUIRE, "agent");
            asm volatile("s_waitcnt vmcnt(0)" ::: "memory");
        }
    }
    __syncthreads();
}

constexpr int MISC_OFF = 147200;
constexpr int BAR_WORD0 = 1024;
constexpr size_t CTL_ZERO_BYTES = 65536;

template <class T> __device__ __forceinline__ T* opaque_uniform(T* p) {
    const unsigned long long v = (unsigned long long)p;
    unsigned lo = __builtin_amdgcn_readfirstlane((unsigned)v), hi = __builtin_amdgcn_readfirstlane((unsigned)(v >> 32));
    asm volatile("" : "+s"(lo), "+s"(hi));
    return (T*)(((unsigned long long)hi << 32) | lo);
}

__device__ __forceinline__ unsigned dpp_xor1(unsigned v) { return (unsigned)__builtin_amdgcn_update_dpp(0, (int)v, 0xB1, 0xF, 0xF, true); }
__device__ __forceinline__ u32x4 xor1(u32x4 v) { u32x4 r; r.x = dpp_xor1(v.x); r.y = dpp_xor1(v.y); r.z = dpp_xor1(v.z); r.w = dpp_xor1(v.w); return r; }
__device__ __forceinline__ u32x4 pack8(f32x4 v0, f32x4 v1) { u32x4 w; w.x = cvtpk(v0[0], v0[1]); w.y = cvtpk(v0[2], v0[3]); w.z = cvtpk(v1[0], v1[1]); w.w = cvtpk(v1[2], v1[3]); return w; }
template <bool NT> __device__ __forceinline__ void store_pair(bf16_t* gp, size_t pitch, int fr, int fq, u32x4 c0, u32x4 c1) {
    const bool odd = (fr & 1) != 0;
    const u32x4 x = xor1(odd ? c0 : c1);
    bf16_t* p = gp - (odd ? pitch : 0) + (odd ? 32 : 0) + 8 * fq;
    const u32x4 d0 = odd ? x : c0, d1 = odd ? c1 : x;
    if (NT) { __builtin_nontemporal_store(d0, (u32x4*)p); __builtin_nontemporal_store(d1, (u32x4*)(p + pitch)); }
    else { *(u32x4*)p = d0; *(u32x4*)(p + pitch) = d1; }
}
__device__ __forceinline__ void load_pair(const bf16_t* gp, size_t pitch, int fr, int fq, u32x4& c0, u32x4& c1) {
    const bool odd = (fr & 1) != 0;
    const bf16_t* p = gp - (odd ? pitch : 0) + (odd ? 32 : 0) + 8 * fq;
    const u32x4 d0 = *(const u32x4*)p, d1 = *(const u32x4*)(p + pitch);
    const u32x4 y = xor1(odd ? d0 : d1);
    c0 = odd ? y : d0; c1 = odd ? d1 : y;
}
struct EpiIn {
    static constexpr bool PERM = true, AFTER_DRAIN = false;
    const float* SS; bf16_t* QB; bf16_t* KB; bf16_t* VB; bf16_t* UB; float* out; int layer;
    __device__ __forceinline__ void operator()(const f32x4 (&acc)[2][2][4][2], const pg8::Unit& u, int wr, int wc, int fr, int fq) const {
        const int row0 = u.pm * 256 + wr * 64 + fr;
        float rsd[2][4];
#pragma unroll
        for (int ai = 0; ai < 2; ++ai)
#pragma unroll
            for (int m = 0; m < 4; ++m) rsd[ai][m] = SS[row0 + ai * 128 + m * 16];
#pragma unroll
        for (int ai = 0; ai < 2; ++ai)
#pragma unroll
            for (int m = 0; m < 4; ++m) rsd[ai][m] = __builtin_amdgcn_rsqf(rsd[ai][m] * (1.0f / 1024.0f) + EPS);
        if (u.pn < 2) {
#pragma unroll
            for (int ai = 0; ai < 2; ++ai)
#pragma unroll
                for (int m = 0; m < 4; ++m) {
                    const int row = row0 + ai * 128 + m * 16; const float sc = rsd[ai][m] * C2;
                    store_pair<false>(QB + (size_t)row * 512 + u.pn * 256 + wc * 64, 512, fr, fq, pack8(acc[ai][0][m][0] * sc, acc[ai][0][m][1] * sc), pack8(acc[ai][1][m][0] * sc, acc[ai][1][m][1] * sc));
                }
        } else if (u.pn == 2) {
            bf16_t* T = wc < 2 ? KB : VB; const int cg = (wc & 1) * 64;
#pragma unroll
            for (int ai = 0; ai < 2; ++ai)
#pragma unroll
                for (int m = 0; m < 4; ++m) {
                    const int row = row0 + ai * 128 + m * 16; const float sc = rsd[ai][m];
                    long od = -1;
                    size_t ob = 0;
                    if (row < MP) { const int b = row >> 12, t = row & 4095; if (t >= 3968) { od = (long)((layer * 16 + b) * 128 + (t - 3968)); ob = wc < 2 ? O_KP : O_VP; } }
                    else { const int rs = row - MP, b = rs >> 6, t = rs & 63; od = (long)((layer * 32 + b) * 128 + 64 + t); ob = wc < 2 ? O_KS : O_VS; }
                    const f32x4 a0 = acc[ai][0][m][0] * sc, a1 = acc[ai][0][m][1] * sc, b0 = acc[ai][1][m][0] * sc, b1 = acc[ai][1][m][1] * sc;
                    store_pair<false>(T + (size_t)row * 128 + cg, 128, fr, fq, pack8(a0, a1), pack8(b0, b1));
                    if (od >= 0) { float* o = out + ob + (size_t)od * 128 + cg + 8 * fq; *(f32x4*)o = a0; *(f32x4*)(o + 4) = a1; *(f32x4*)(o + 32) = b0; *(f32x4*)(o + 36) = b1; }
                }
        } else {
            const int ch0 = (u.pn - 3) * 128 + wc * 32 + 8 * fq;
#pragma unroll
            for (int ai = 0; ai < 2; ++ai)
#pragma unroll
                for (int m = 0; m < 4; ++m) {
                    const int row = row0 + ai * 128 + m * 16; const float sc = rsd[ai][m];
                    long od = -1; size_t oc = 0;
                    if (row < MP) { const int b = row >> 12, t = row & 4095; if (t >= 4066) { od = (long)((layer * 16 + b) * 30 + (t - 4066)); oc = O_CP; } }
                    else { const int rs = row - MP, b = rs >> 6, t = rs & 63; if (t >= 34) { od = (long)((layer * 32 + b) * 30 + (t - 34)); oc = O_CS; } }
                    f32x4 u0, u1;
#pragma unroll
                    for (int i = 0; i < 4; ++i) { u0[i] = acc[ai][0][m][0][i] * sc * sigmoid_f(acc[ai][1][m][0][i] * sc); u1[i] = acc[ai][0][m][1][i] * sc * sigmoid_f(acc[ai][1][m][1][i] * sc); }
                    *(u32x4*)(UB + (size_t)row * 512 + ch0) = pack8(u0, u1);
                    if (od >= 0) { float* o = out + oc + (size_t)od * 512 + ch0; *(f32x4*)o = u0; *(f32x4*)(o + 4) = u1; }
                }
        }
    }
};
struct EpiRes {
    static constexpr bool PERM = true, AFTER_DRAIN = false;
    bf16_t* xb; float* SS;
    __device__ __forceinline__ void operator()(const f32x4 (&acc)[2][2][4][2], const pg8::Unit& u, int wr, int wc, int fr, int fq) const {
        const int row0 = u.pm * 256 + wr * 64 + fr, cg = u.pn * 256 + wc * 64;
#pragma unroll
        for (int ai = 0; ai < 2; ++ai)
#pragma unroll
        for (int mh = 0; mh < 2; ++mh) {
            u32x4 r0[2], r1[2];
#pragma unroll
            for (int mm = 0; mm < 2; ++mm) load_pair(xb + (size_t)(row0 + ai * 128 + (mh * 2 + mm) * 16) * DM + cg, DM, fr, fq, r0[mm], r1[mm]);
#pragma unroll
            for (int mm = 0; mm < 2; ++mm) {
                const int m = mh * 2 + mm, row = row0 + ai * 128 + m * 16;
                const f32x4 v0 = acc[ai][0][m][0] + (f32x4){bf_lo(r0[mm].x), bf_hi(r0[mm].x), bf_lo(r0[mm].y), bf_hi(r0[mm].y)}, v1 = acc[ai][0][m][1] + (f32x4){bf_lo(r0[mm].z), bf_hi(r0[mm].z), bf_lo(r0[mm].w), bf_hi(r0[mm].w)};
                const f32x4 w0 = acc[ai][1][m][0] + (f32x4){bf_lo(r1[mm].x), bf_hi(r1[mm].x), bf_lo(r1[mm].y), bf_hi(r1[mm].y)}, w1 = acc[ai][1][m][1] + (f32x4){bf_lo(r1[mm].z), bf_hi(r1[mm].z), bf_lo(r1[mm].w), bf_hi(r1[mm].w)};
                store_pair<false>(xb + (size_t)row * DM + cg, DM, fr, fq, pack8(v0, v1), pack8(w0, w1));
                float sq = (v0[0] * v0[0] + v0[1] * v0[1]) + (v0[2] * v0[2] + v0[3] * v0[3]) + (v1[0] * v1[0] + v1[1] * v1[1]) + (v1[2] * v1[2] + v1[3] * v1[3]);
                sq += (w0[0] * w0[0] + w0[1] * w0[1]) + (w0[2] * w0[2] + w0[3] * w0[3]) + (w1[0] * w1[0] + w1[1] * w1[1]) + (w1[2] * w1[2] + w1[3] * w1[3]);
                sq += __shfl_xor(sq, 16); sq += __shfl_xor(sq, 32);
                if (fq == 0) (void)__hip_atomic_fetch_add(SS + row, sq, __ATOMIC_RELAXED, __HIP_MEMORY_SCOPE_AGENT);
            }
            asm volatile("" ::: "memory");
        }
    }
};
struct EpiUp {
    static constexpr bool PERM = true, AFTER_DRAIN = false;
    const float* SS; bf16_t* HB;
    __device__ __forceinline__ void operator()(const f32x4 (&acc)[2][2][4][2], const pg8::Unit& u, int wr, int wc, int fr, int fq) const {
        const int row0 = u.pm * 256 + wr * 64 + fr, cg = u.pn * 256 + wc * 64;
        float rsd[2][4];
#pragma unroll
        for (int ai = 0; ai < 2; ++ai)
#pragma unroll
            for (int m = 0; m < 4; ++m) rsd[ai][m] = SS[row0 + ai * 128 + m * 16];
#pragma unroll
        for (int ai = 0; ai < 2; ++ai)
#pragma unroll
            for (int m = 0; m < 4; ++m) rsd[ai][m] = __builtin_amdgcn_rsqf(rsd[ai][m] * (1.0f / 1024.0f) + EPS);
#pragma unroll
        for (int ai = 0; ai < 2; ++ai)
#pragma unroll
            for (int m = 0; m < 4; ++m) {
                const int row = row0 + ai * 128 + m * 16; const float sc = rsd[ai][m];
                u32x4 c[2];
#pragma unroll
                for (int bj = 0; bj < 2; ++bj) { f32x4 v0 = acc[ai][bj][m][0] * sc, v1 = acc[ai][bj][m][1] * sc;
#pragma unroll
                    for (int i = 0; i < 4; ++i) { const float a = fmaxf(v0[i], 0.f), b = fmaxf(v1[i], 0.f); v0[i] = a * a; v1[i] = b * b; }
                    c[bj] = pack8(v0, v1); }
                store_pair<true>(HB + (size_t)row * FF + cg, FF, fr, fq, c[0], c[1]);
            }
    }
};

struct EpiPart {
    static constexpr bool PERM = true, AFTER_DRAIN = false;
    float* part;
    __device__ __forceinline__ void operator()(const f32x4 (&acc)[2][2][4][2], const pg8::Unit& u, int wr, int wc, int fr, int fq) const {
        const int row0 = u.pm * 256 + wr * 64 + fr - MP, col0 = u.pn * 256 + wc * 64 + 8 * fq;
        float* base = part + (size_t)u.kz * MS * DM;
#pragma unroll
        for (int ai = 0; ai < 2; ++ai)
#pragma unroll
            for (int m = 0; m < 4; ++m) { float* op = base + (size_t)(row0 + ai * 128 + m * 16) * DM + col0;
#pragma unroll
                for (int bj = 0; bj < 2; ++bj) { *(f32x4*)(op + bj * 32) = acc[ai][bj][m][0]; *(f32x4*)(op + bj * 32 + 4) = acc[ai][bj][m][1]; } }
    }
};
struct EpiAll {
    static constexpr bool PERM = true, AFTER_DRAIN = false;
    int kind, layer, ssr, ssw; unsigned char* ws; float* out;
    __device__ __forceinline__ void operator()(const f32x4 (&acc)[2][2][4][2], const pg8::Unit& u, int wr, int wc, int fr_, int fq_) const {
        int lane = (int)__builtin_amdgcn_mbcnt_hi(~0u, __builtin_amdgcn_mbcnt_lo(~0u, 0u)); asm volatile("" : "+v"(lane));
        const int fr = lane & 15, fq = (lane >> 4) & 3;
        unsigned char* ws = opaque_uniform(this->ws); float* out = opaque_uniform(this->out);
        const float* SS = (const float*)(ws + WS_SS) + (size_t)ssr * M; float* SSW = (float*)(ws + WS_SS) + (size_t)ssw * M;
        if (kind == 0) { EpiIn E{SS, (bf16_t*)(ws + WS_Q), (bf16_t*)(ws + WS_K), (bf16_t*)(ws + WS_V), (bf16_t*)(ws + WS_U), out, layer}; E(acc, u, wr, wc, fr, fq); }
        else if (kind == 1) { EpiRes E{(bf16_t*)(ws + WS_XB), SSW}; E(acc, u, wr, wc, fr, fq); }
        else if (kind == 2) { EpiUp E{SS, (bf16_t*)(ws + WS_H)}; E(acc, u, wr, wc, fr, fq); }
        else if (kind == 3) { EpiPart E{(float*)(ws + WS_PART)}; E(acc, u, wr, wc, fr, fq); }
        else { if (acc[0][0][0][0][0] == 123.456f) out[0] = 0.f; }
    }
};

struct Args { const float* in[17]; float* out; unsigned char* ws; int ph_lo, ph_hi; };
enum { I_XP = 0, I_XS, I_CK, I_CV, I_SC, I_N1, I_WIN, I_SINK, I_CW, I_CB, I_LG, I_LB, I_WOUT, I_N2, I_WUP, I_WDN, I_FN };

__device__ __forceinline__ void transpose_item(const float* W, int K, int N, bf16_t* WT, const float* g, int mode, LAS float* scr, int item, int lane) {
    const int nblk = N / 32, kb = item / nblk, nb = item % nblk, k0 = 64 * kb, n0 = 32 * nb;
    float wv[32], gv[32];
#pragma unroll
    for (int i = 0; i < 32; ++i) { const int kk = 2 * i + (lane >> 5); wv[i] = W[(size_t)(k0 + kk) * N + n0 + (lane & 31)]; gv[i] = g ? g[k0 + kk] : 1.0f; }
#pragma unroll
    for (int i = 0; i < 32; ++i) { const int kk = 2 * i + (lane >> 5); scr[kk * 33 + (lane & 31)] = wv[i] * gv[i]; }
    asm volatile("s_waitcnt lgkmcnt(0)" ::: "memory");
    int dn0 = n0;
    if (mode == 1 && n0 >= 768) { int c = n0 - 768; const int gofs = c < 512 ? 0 : 32; if (c >= 512) c -= 512; dn0 = 768 + (c >> 7) * 256 + ((c >> 5) & 3) * 64 + gofs + (c & 31); }
    const int c = lane & 7;
#pragma unroll
    for (int j = 0; j < 4; ++j) { const int n = (lane >> 3) + 8 * j; const LAS float* s = scr + (8 * c) * 33 + n;
        u32x4 o; o.x = cvtpk(s[0 * 33], s[1 * 33]); o.y = cvtpk(s[2 * 33], s[3 * 33]); o.z = cvtpk(s[4 * 33], s[5 * 33]); o.w = cvtpk(s[6 * 33], s[7 * 33]);
        *(u32x4*)(WT + (size_t)(dn0 + n) * K + k0 + 8 * c) = o; }
    asm volatile("s_waitcnt lgkmcnt(0)" ::: "memory");
}
__device__ __forceinline__ void prologue(LAS unsigned char* lds, const Args& a, const int tid, const int bid) {
    const int lane = tid & 63, wave = __builtin_amdgcn_readfirstlane(tid >> 6), G = gridDim.x;
    const int gw = bid * 8 + wave, NGW = G * 8;
    unsigned char* ws = a.ws;
    LAS float* scr = (LAS float*)(lds + wave * 16384);
    constexpr int I_IN = 16 * (NIN / 32), I_OUT = 16 * (DM / 32), I_UP = 16 * (FF / 32), I_DN = 64 * (DM / 32), I_L = I_IN + I_OUT + I_UP + I_DN;
    for (int it = gw; it < 2 * I_L; it += NGW) {
        const int l = it / I_L; int r = it % I_L;
        if (r < I_IN) { transpose_item(a.in[I_WIN] + (size_t)l * DM * NIN, DM, NIN, (bf16_t*)(ws + WS_WIN) + (size_t)l * NIN * DM, a.in[I_N1] + l * DM, 1, scr, r, lane); continue; } r -= I_IN;
        if (r < I_OUT) { transpose_item(a.in[I_WOUT] + (size_t)l * DM * DM, DM, DM, (bf16_t*)(ws + WS_WOUT) + (size_t)l * DM * DM, nullptr, 0, scr, r, lane); continue; } r -= I_OUT;
        if (r < I_UP) { transpose_item(a.in[I_WUP] + (size_t)l * DM * FF, DM, FF, (bf16_t*)(ws + WS_WUP) + (size_t)l * FF * DM, a.in[I_N2] + l * DM, 0, scr, r, lane); continue; } r -= I_UP;
        transpose_item(a.in[I_WDN] + (size_t)l * FF * DM, FF, DM, (bf16_t*)(ws + WS_WDN) + (size_t)l * DM * FF, nullptr, 0, scr, r, lane);
    }
    bf16_t* XB = (bf16_t*)(ws + WS_XB); float* SS = (float*)(ws + WS_SS);
    for (int m0 = gw; m0 < M; m0 += 2 * NGW) {
        const int m1 = m0 + NGW; const bool two = m1 < M; const int m1c = two ? m1 : m0;
        const float* xr0 = m0 < MP ? a.in[I_XP] + (size_t)m0 * DM : a.in[I_XS] + (size_t)(m0 - MP) * DM;
        const float* xr1 = m1c < MP ? a.in[I_XP] + (size_t)m1c * DM : a.in[I_XS] + (size_t)(m1c - MP) * DM;
        const f32x4* xa = (const f32x4*)xr0 + lane; const f32x4* xb_ = (const f32x4*)xr1 + lane;
        f32x4 v[4], w4[4]; float s0 = 0.f, s1 = 0.f;
#pragma unroll
        for (int j = 0; j < 4; ++j) v[j] = xa[64 * j];
#pragma unroll
        for (int j = 0; j < 4; ++j) w4[j] = xb_[64 * j];
#pragma unroll
        for (int j = 0; j < 4; ++j) { s0 += (v[j][0] * v[j][0] + v[j][1] * v[j][1]) + (v[j][2] * v[j][2] + v[j][3] * v[j][3]); s1 += (w4[j][0] * w4[j][0] + w4[j][1] * w4[j][1]) + (w4[j][2] * w4[j][2] + w4[j][3] * w4[j][3]); }
        s0 = wave_sum(s0); s1 = wave_sum(s1);
        u32x2* o0 = (u32x2*)(XB + (size_t)m0 * DM) + lane;
#pragma unroll
        for (int j = 0; j < 4; ++j) { u32x2 w; w.x = cvtpk(v[j][0], v[j][1]); w.y = cvtpk(v[j][2], v[j][3]); o0[64 * j] = w; }
        if (lane < 5) SS[(size_t)lane * M + m0] = lane == 0 ? s0 : 0.f;
        if (two) {
            u32x2* o1 = (u32x2*)(XB + (size_t)m1 * DM) + lane;
#pragma unroll
            for (int j = 0; j < 4; ++j) { u32x2 w; w.x = cvtpk(w4[j][0], w4[j][1]); w.y = cvtpk(w4[j][2], w4[j][3]); o1[64 * j] = w; }
            if (lane < 5) SS[(size_t)lane * M + m1] = lane == 0 ? s1 : 0.f;
        }
    }
    const int gt = bid * 512 + tid, GT = G * 512;
    float* out = a.out;
    constexpr int NC = 2 * 32 * 128 * 128 / 4, NS = 2 * 32 * 30 * 512 / 4;
    for (int i0 = gt; i0 < NC; i0 += 2 * GT) {
        const int i1 = i0 + GT; const bool two = i1 < NC; const int i1c = two ? i1 : i0;
        const f32x4 k0v = ((const f32x4*)a.in[I_CK])[i0], v0v = ((const f32x4*)a.in[I_CV])[i0], k1v = ((const f32x4*)a.in[I_CK])[i1c], v1v = ((const f32x4*)a.in[I_CV])[i1c];
#pragma unroll
        for (int t = 0; t < 2; ++t) { if (t == 1 && !two) break; const int i = t ? i1 : i0; const f32x4 kv = t ? k1v : k0v, vv = t ? v1v : v0v;
            u32x2 wk, wv; wk.x = cvtpk(kv[0], kv[1]); wk.y = cvtpk(kv[2], kv[3]); wv.x = cvtpk(vv[0], vv[1]); wv.y = cvtpk(vv[2], vv[3]);
            ((u32x2*)(ws + WS_CK))[i] = wk; ((u32x2*)(ws + WS_CV))[i] = wv;
            const int e = 4 * i, row = (e >> 7) & 127;
            if (row >= 64) { const int lb = e >> 14; const size_t dst = ((size_t)lb * 128 + (row - 64)) * 128 + (e & 127); *(f32x4*)(out + O_KS + dst) = kv; *(f32x4*)(out + O_VS + dst) = vv; } }
    }
    for (int i0 = gt; i0 < NS; i0 += 2 * GT) {
        const int i1 = i0 + GT; const bool two = i1 < NS; const f32x4 a0 = ((const f32x4*)a.in[I_SC])[i0], a1 = ((const f32x4*)a.in[I_SC])[two ? i1 : i0];
        u32x2 w; w.x = cvtpk(a0[0], a0[1]); w.y = cvtpk(a0[2], a0[3]); ((u32x2*)(ws + WS_SC))[i0] = w;
        if (two) { w.x = cvtpk(a1[0], a1[1]); w.y = cvtpk(a1[2], a1[3]); ((u32x2*)(ws + WS_SC))[i1] = w; }
    }
}

constexpr int CW_OFF = 0, CIN_OFF = 31 * 512 * 4, RED_OFF = CIN_OFF + 62 * 1024;
__device__ __forceinline__ void conv_stage_weights(LAS unsigned char* lds, const float* cw, const int tid) {
    for (int i = tid; i < 31 * 512 / 4; i += 512) *(LAS f32x4*)(lds + CW_OFF + i * 16) = ((const f32x4*)cw)[i];
}
__device__ __forceinline__ size_t conv_row0(int hc, bool& smp, int& c, int& sb) {
    const int gc = hc >> 1, half = hc & 1; smp = gc >= 1024; c = 0; sb = 0; size_t r0;
    if (!smp) { const int b = gc >> 6; c = gc & 63; r0 = (size_t)b * 4096 + c * 64; } else { sb = gc - 1024; r0 = (size_t)MP + sb * 64; }
    return r0 + half * 32;
}
__device__ __forceinline__ void conv_fetch(u32x4 (&rg)[8], const bf16_t* UB, const bf16_t* SCB_l, int hc, const int tid) {
    bool smp; int c, sb; const size_t tok0 = conv_row0(hc, smp, c, sb); const int half = hc & 1;
#pragma unroll
    for (int j = 0; j < 8; ++j) {
        const int idx = tid + 512 * j, i = idx >> 6, pc = idx & 63; u32x4 v = {0u, 0u, 0u, 0u};
        if (idx < 62 * 64) {
            if (half == 1 || i >= 30) v = *(const u32x4*)(UB + (tok0 + i - 30) * 512 + pc * 8);
            else if (smp) v = *(const u32x4*)(SCB_l + ((size_t)sb * 30 + i) * 512 + pc * 8);
            else if (c > 0) v = *(const u32x4*)(UB + (tok0 + i - 30) * 512 + pc * 8);
        }
        rg[j] = v;
    }
}
__device__ __forceinline__ void conv_compute(LAS unsigned char* lds, bf16_t* MIX, const f32x2 (&w)[31], const float* cb, const float* lg, const float* lb, int hc, const int tid) {
    const int lane = tid & 63, wid = __builtin_amdgcn_readfirstlane(tid >> 6);
    bool smp; int c, sb; const size_t tok0 = conv_row0(hc, smp, c, sb);
    const int cp = tid & 255, th = wid >> 2;
#pragma unroll 1
    for (int tg = 0; tg < 2; ++tg) {
        const int t0 = th * 16 + tg * 8;
        f32x2 in[38];
#pragma unroll
        for (int i = 0; i < 38; ++i) { const unsigned u = *(const LAS unsigned*)(lds + CIN_OFF + (t0 + i) * 1024 + cp * 4); in[i] = (f32x2){bf_lo(u), bf_hi(u)}; }
        f32x2 h[8];
        const f32x2 bias = *(const f32x2*)(cb + 2 * cp);
#pragma unroll
        for (int k = 0; k < 8; ++k) h[k] = bias;
#pragma unroll
        for (int j = 0; j < 31; ++j) { const f32x2 wj = w[j];
#pragma unroll
            for (int k = 0; k < 8; ++k) h[k] = wj * in[k + j] + h[k]; }
        float st[16];
#pragma unroll
        for (int k = 0; k < 8; ++k) { st[k] = h[k].x + h[k].y; st[8 + k] = h[k].x * h[k].x + h[k].y * h[k].y; }
        float s8[8], s4[4], s2[2], s1;
        { const bool up = (lane & 32) != 0;
#pragma unroll
          for (int k = 0; k < 8; ++k) { const float keep = up ? st[8 + k] : st[k], send = up ? st[k] : st[8 + k]; s8[k] = keep + __shfl_xor(send, 32); } }
        { const bool up = (lane & 16) != 0;
#pragma unroll
          for (int k = 0; k < 4; ++k) { const float keep = up ? s8[4 + k] : s8[k], send = up ? s8[k] : s8[4 + k]; s4[k] = keep + __shfl_xor(send, 16); } }
        { const bool up = (lane & 8) != 0;
#pragma unroll
          for (int k = 0; k < 2; ++k) { const float keep = up ? s4[2 + k] : s4[k], send = up ? s4[k] : s4[2 + k]; s2[k] = keep + __shfl_xor(send, 8); } }
        { const bool up = (lane & 4) != 0; const float keep = up ? s2[1] : s2[0], send = up ? s2[0] : s2[1]; s1 = keep + __shfl_xor(send, 4); }
        s1 += __shfl_xor(s1, 2); s1 += __shfl_xor(s1, 1);
        if ((lane & 3) == 0) { const int v = ((lane >> 5) & 1) * 8 + ((lane >> 4) & 1) * 4 + ((lane >> 3) & 1) * 2 + ((lane >> 2) & 1);
            *(LAS float*)(lds + RED_OFF + (tg * 8 + wid) * 64 + v * 4) = s1; }
        __syncthreads();
        float tot[16];
#pragma unroll
        for (int k = 0; k < 16; ++k) tot[k] = 0.f;
#pragma unroll
        for (int w4 = 0; w4 < 4; ++w4) { const LAS f32x4* rp = (const LAS f32x4*)(lds + RED_OFF + (tg * 8 + th * 4 + w4) * 64);
#pragma unroll
            for (int q = 0; q < 4; ++q) { const f32x4 v = rp[q]; tot[4 * q] += v[0]; tot[4 * q + 1] += v[1]; tot[4 * q + 2] += v[2]; tot[4 * q + 3] += v[3]; } }
        unsigned* op = (unsigned*)(MIX + (tok0 + t0) * 1024 + 512 + 2 * cp);
        const f32x2 gg = *(const f32x2*)(lg + 2 * cp), bb = *(const f32x2*)(lb + 2 * cp);
#pragma unroll
        for (int k = 0; k < 8; ++k) {
            const float mean = tot[k] * (1.0f / 512.0f), var = tot[8 + k] * (1.0f / 512.0f) - mean * mean;
            const float rstd = __builtin_amdgcn_rsqf(fmaxf(var, 0.f) + EPS);
            f32x2 y = (h[k] - mean) * rstd * gg + bb;
            y.x = y.x * sigmoid_f(y.x); y.y = y.y * sigmoid_f(y.y);
            op[(size_t)k * 512] = cvtpk(y.x, y.y);
        }
    }
}
__device__ __forceinline__ void conv_units(LAS unsigned char* lds, const bf16_t* UB, const bf16_t* SCB_l, bf16_t* MIX, const float* cw, const float* cb, const float* lg, const float* lb, const int tid, const int bid, const int G) {
    f32x2 w[31];
#pragma unroll
    for (int j = 0; j < 31; ++j) w[j] = *(const f32x2*)(cw + j * 512 + 2 * (tid & 255));
    u32x4 rg[8];
    int it = bid;
    if (it < 2112) conv_fetch(rg, UB, SCB_l, it, tid);
#pragma unroll 1
    for (; it < 2112; it += G) {
        __syncthreads();
#pragma unroll
        for (int j = 0; j < 8; ++j) { const int idx = tid + 512 * j; if (idx < 62 * 64) *(LAS u32x4*)(lds + CIN_OFF + (idx >> 6) * 1024 + (idx & 63) * 16) = rg[j]; }
        __syncthreads();
        if (it + G < 2112) conv_fetch(rg, UB, SCB_l, it + G, tid);
        conv_compute(lds, MIX, w, cb, lg, lb, it, tid);
    }
}

__device__ __forceinline__ int crow(int r, int h) { return (r & 3) + 8 * (r >> 2) + 4 * h; }
struct AttnRegs { u32x4 k[3], v[3]; bf16x8 q[4]; };
__device__ __forceinline__ size_t attn_rows(int unit, bool& smp, int& first, int& sb) {
    const int gc = unit >> 1; smp = gc >= 1024; first = 0; sb = 0; size_t qrow0;
    if (!smp) { const int b = gc >> 6, c = gc & 63; qrow0 = (size_t)b * 4096 + c * 64; first = c >= 2 ? 0 : 2 - c; } else { sb = gc - 1024; qrow0 = (size_t)MP + sb * 64; }
    return qrow0;
}
__device__ __forceinline__ void attn_fetch(AttnRegs& R, const bf16_t* QB, const bf16_t* KB, const bf16_t* VB, const bf16_t* CKB_l, const bf16_t* CVB_l, int unit, const int tid) {
    const int lane = tid & 63, wid = __builtin_amdgcn_readfirstlane(tid >> 6), r32 = lane & 31, hi = lane >> 5, kh = unit & 1;
    bool smp; int first, sb; const size_t qrow0 = attn_rows(unit, smp, first, sb);
    { const int kv = tid >> 3, dg = tid & 7;
#pragma unroll
        for (int j = 0; j < 3; ++j) { R.k[j] = (u32x4){0u, 0u, 0u, 0u}; if (j >= first) {
            const bf16_t* src = (smp && j < 2) ? CKB_l + ((size_t)sb * 128 + j * 64) * 128 : KB + (qrow0 + j * 64 - 128) * 128;
            R.k[j] = *(const u32x4*)(src + (size_t)kv * 128 + kh * 64 + dg * 8); } } }
    { const int kv = tid & 63, dg = wid;
#pragma unroll
        for (int j = 0; j < 3; ++j) { R.v[j] = (u32x4){0u, 0u, 0u, 0u}; if (j >= first) {
            const bf16_t* src = (smp && j < 2) ? CVB_l + ((size_t)sb * 128 + j * 64) * 128 : VB + (qrow0 + j * 64 - 128) * 128;
            R.v[j] = *(const u32x4*)(src + (size_t)kv * 128 + kh * 64 + dg * 8); } } }
    const int g = wid >> 1, qh = wid & 1, head = kh * 4 + g;
    const bf16_t* qp = QB + (qrow0 + qh * 32 + r32) * 512 + head * 64 + hi * 8;
#pragma unroll
    for (int d0 = 0; d0 < 4; ++d0) R.q[d0] = *(const bf16x8*)(qp + d0 * 16);
}
constexpr int KOFF = 0, KSTR = 144, VOFF = 192 * 144, VSTR = 400;
__device__ __forceinline__ void attn_stage(LAS unsigned char* lds, const AttnRegs& R, const int tid) {
    const int wid = __builtin_amdgcn_readfirstlane(tid >> 6);
    { const int kv = tid >> 3, dg = tid & 7;
#pragma unroll
        for (int j = 0; j < 3; ++j) *(LAS u32x4*)(lds + KOFF + (j * 64 + kv) * KSTR + dg * 16) = R.k[j]; }
    { const int kv = tid & 63, dg = wid;
#pragma unroll
        for (int j = 0; j < 3; ++j) { const u32x4 v = R.v[j];
            const int w = j * 64 + kv, slot = (w & ~12) | ((w & 4) << 1) | ((w & 8) >> 1);
            LAS unsigned short* dst = (LAS unsigned short*)(lds + VOFF + (dg * 8) * VSTR + slot * 2);
#pragma unroll
            for (int i = 0; i < 8; ++i) dst[i * (VSTR / 2)] = (unsigned short)(v[i >> 1] >> (16 * (i & 1))); } }
}
__device__ __forceinline__ void attn_compute(LAS unsigned char* lds, const bf16x8 (&qf)[4], bf16_t* MIX, const float* sink_l, int unit, const int tid) {
    const int lane = tid & 63, wid = __builtin_amdgcn_readfirstlane(tid >> 6), r32 = lane & 31, hi = lane >> 5, kh = unit & 1;
    bool smp; int first, sb; const size_t qrow0 = attn_rows(unit, smp, first, sb);
    const int g = wid >> 1, qh = wid & 1, head = kh * 4 + g;
    const float sk = sink_l[head] * LOG2E;
    f32x16 p[6];
#pragma unroll
    for (int kt = 0; kt < 6; ++kt) {
        if ((kt >> 1) >= first) {
            f32x16 acc;
#pragma unroll
            for (int i = 0; i < 16; ++i) acc[i] = 0.f;
#pragma unroll
            for (int d0 = 0; d0 < 4; ++d0) { const bf16x8 kf = *(const LAS bf16x8*)(lds + KOFF + (kt * 32 + r32) * KSTR + (d0 * 16 + hi * 8) * 2);
                acc = __builtin_amdgcn_mfma_f32_32x32x16_bf16(kf, qf[d0], acc, 0, 0, 0); }
            p[kt] = acc;
        } else {
#pragma unroll
            for (int i = 0; i < 16; ++i) p[kt][i] = -1e30f;
        }
    }
    float mx = sk;
#pragma unroll
    for (int kt = 0; kt < 6; ++kt)
#pragma unroll
        for (int i = 0; i < 16; ++i) mx = fmaxf(mx, p[kt][i]);
    mx = fmaxf(mx, __shfl_xor(mx, 32));
    float sum = 0.f;
#pragma unroll
    for (int kt = 0; kt < 6; ++kt)
#pragma unroll
        for (int i = 0; i < 16; ++i) { const float e = __builtin_amdgcn_exp2f(p[kt][i] - mx); p[kt][i] = e; sum += e; }
    sum += __shfl_xor(sum, 32);
    const float inv = 1.0f / (sum + __builtin_amdgcn_exp2f(sk - mx));
    f32x16 o0, o1;
#pragma unroll
    for (int i = 0; i < 16; ++i) { o0[i] = 0.f; o1[i] = 0.f; }
#pragma unroll
    for (int kt = 0; kt < 6; ++kt) if ((kt >> 1) >= first) {
#pragma unroll
        for (int s = 0; s < 2; ++s) {
            u32x4 pw; pw.x = cvtpk(p[kt][8 * s] * inv, p[kt][8 * s + 1] * inv); pw.y = cvtpk(p[kt][8 * s + 2] * inv, p[kt][8 * s + 3] * inv);
            pw.z = cvtpk(p[kt][8 * s + 4] * inv, p[kt][8 * s + 5] * inv); pw.w = cvtpk(p[kt][8 * s + 6] * inv, p[kt][8 * s + 7] * inv);
            const bf16x8 pa = __builtin_bit_cast(bf16x8, pw);
            const bf16x8 v0 = *(const LAS bf16x8*)(lds + VOFF + r32 * VSTR + (kt * 32 + s * 16 + hi * 8) * 2);
            const bf16x8 v1 = *(const LAS bf16x8*)(lds + VOFF + (32 + r32) * VSTR + (kt * 32 + s * 16 + hi * 8) * 2);
            o0 = __builtin_amdgcn_mfma_f32_32x32x16_bf16(pa, v0, o0, 0, 0, 0);
            o1 = __builtin_amdgcn_mfma_f32_32x32x16_bf16(pa, v1, o1, 0, 0, 0);
        }
    }
    bf16_t* op = MIX + (qrow0 + qh * 32) * 1024 + head * 64 + r32;
#pragma unroll
    for (int i = 0; i < 16; ++i) { const int q = crow(i, hi);
        op[(size_t)q * 1024] = (bf16_t)(cvtpk(o0[i], 0.f) & 0xffffu); op[(size_t)q * 1024 + 32] = (bf16_t)(cvtpk(o1[i], 0.f) & 0xffffu); }
}
__device__ __forceinline__ void attn_units(LAS unsigned char* lds, const bf16_t* QB, const bf16_t* KB, const bf16_t* VB, const bf16_t* CKB_l, const bf16_t* CVB_l, bf16_t* MIX, const float* sink_l, const int tid, const int bid, const int G) {
    AttnRegs R;
    int it = G - 1 - bid;
    if (it < 2112) attn_fetch(R, QB, KB, VB, CKB_l, CVB_l, it, tid);
#pragma unroll 1
    for (; it < 2112; it += G) {
        __syncthreads();
        attn_stage(lds, R, tid);
        bf16x8 qf[4];
#pragma unroll
        for (int d0 = 0; d0 < 4; ++d0) qf[d0] = R.q[d0];
        __syncthreads();
        if (it + G < 2112) attn_fetch(R, QB, KB, VB, CKB_l, CVB_l, it + G, tid);
        attn_compute(lds, qf, MIX, sink_l, it, tid);
    }
}

__device__ __forceinline__ void combine_sample_rows(unsigned char* ws, int ssw, const int tid, const int bid, const int G) {
    const int lane = tid & 63, wave = tid >> 6, gw = bid * 8 + wave, NGW = G * 8;
    const float* part = (const float*)(ws + WS_PART); bf16_t* XB = (bf16_t*)(ws + WS_XB); float* SS = (float*)(ws + WS_SS) + (size_t)ssw * M;
    for (int r = gw; r < MS; r += NGW) {
        const int row = MP + r; u32x2* o8 = (u32x2*)(XB + (size_t)row * DM) + lane;
        f32x4 v[4];
#pragma unroll
        for (int j = 0; j < 4; ++j) { const u32x2 x = o8[64 * j]; v[j] = (f32x4){bf_lo(x.x), bf_hi(x.x), bf_lo(x.y), bf_hi(x.y)}; }
#pragma unroll
        for (int kz = 0; kz < 8; ++kz) { const f32x4* pp = (const f32x4*)(part + ((size_t)kz * MS + r) * DM) + lane;
#pragma unroll
            for (int j = 0; j < 4; ++j) v[j] += pp[64 * j]; }
        float sq = 0.f;
#pragma unroll
        for (int j = 0; j < 4; ++j) { u32x2 w; w.x = cvtpk(v[j][0], v[j][1]); w.y = cvtpk(v[j][2], v[j][3]); o8[64 * j] = w;
            sq += (v[j][0] * v[j][0] + v[j][1] * v[j][1]) + (v[j][2] * v[j][2] + v[j][3] * v[j][3]); }
        sq = wave_sum(sq);
        if (lane == 0) SS[row] = sq;
    }
}

constexpr int N_PHASES = 14, PPL = 6;
#ifndef MK_PER_PHASE
#define MK_PER_PHASE 0
#endif
#ifndef PROBE_REPEAT_PH
#define PROBE_REPEAT_PH 0
#define PROBE_NREP 0
#endif
#ifndef PROBE_NOEPI
#define PROBE_NOEPI 0
#endif

__device__ __forceinline__ void phase_gemm(LAS unsigned char* lds, unsigned char* ws, float* out, int l, int k, const int tid, const int bid, const int G, const bool noepi = false) {
    const int npass = (k == 4) ? 2 : 1;
#pragma unroll 1
    for (int pass = 0; pass < npass; ++pass) {
        pg8::Gemm g; g.M = M; g.ablk = 0; EpiAll E; E.ssr = 0; E.ssw = 0; E.layer = l; E.ws = ws; E.out = out;
        pg8::StaticOrder S; int rows = M; S.mode = 0;
        if (k == 0)      { g.A = (const bf16_t*)(ws + WS_XB);  g.Bt = (const bf16_t*)(ws + WS_WIN) + (size_t)l * NIN * DM; g.N = NIN; g.K = DM; g.KL = DM; E.kind = 0; E.ssr = 2 * l; }
        else if (k == 2) { g.A = (const bf16_t*)(ws + WS_MIX); g.Bt = (const bf16_t*)(ws + WS_WOUT) + (size_t)l * DM * DM; g.N = DM; g.K = DM; g.KL = DM; E.kind = 1; E.ssw = 2 * l + 1; }
        else if (k == 3) { g.A = (const bf16_t*)(ws + WS_XB);  g.Bt = (const bf16_t*)(ws + WS_WUP) + (size_t)l * FF * DM; g.N = FF; g.K = DM; g.KL = DM; E.kind = 2; E.ssr = 2 * l + 1; }
        else             { g.A = (const bf16_t*)(ws + WS_H);   g.Bt = (const bf16_t*)(ws + WS_WDN) + (size_t)l * DM * FF; g.N = DM; g.K = FF; E.ssw = 2 * l + 2;
                           if (pass == 0) { g.KL = FF; E.kind = 1; rows = MP; }
                           else           { g.KL = FF / 8; E.kind = 3; S.mode = 1; } }
        if (noepi) E.kind = 4;
        S.init(rows, g.N, G, bid);
        pg8::gemm_phase<EpiAll, pg8::StaticOrder, true, true>(lds, g, S, E, tid);
    }
}
__device__ __forceinline__ void phase_mixer(LAS unsigned char* lds, unsigned char* ws, const float* cw, const float* cb, const float* lg, const float* lb, const float* sink, int l, const int tid, const int bid, const int G) {
    bf16_t* QB = (bf16_t*)(ws + WS_Q); bf16_t* KB = (bf16_t*)(ws + WS_K); bf16_t* VB = (bf16_t*)(ws + WS_V); bf16_t* UB = (bf16_t*)(ws + WS_U); bf16_t* MIX = (bf16_t*)(ws + WS_MIX);
    const bf16_t* SCB_l = (const bf16_t*)(ws + WS_SC) + (size_t)l * 32 * 30 * 512;
    const bf16_t* CKB_l = (const bf16_t*)(ws + WS_CK) + (size_t)l * 32 * 128 * 128; const bf16_t* CVB_l = (const bf16_t*)(ws + WS_CV) + (size_t)l * 32 * 128 * 128;
    conv_units(lds, UB, SCB_l, MIX, cw + l * 31 * 512, cb + l * 512, lg + l * 512, lb + l * 512, tid, bid, G);
    attn_units(lds, QB, KB, VB, CKB_l, CVB_l, MIX, sink + l * 8, tid, bid, G);
    __syncthreads();
}
__device__ __forceinline__ void final_row(const float* SS, const bf16_t* XB, const float* part, float* out, const float* fn, int m, int lane) {
    f32x4* p = (f32x4*)(out + (size_t)m * DM) + lane; const f32x4* gp = (const f32x4*)fn + lane; const u32x2* xp = (const u32x2*)(XB + (size_t)m * DM) + lane;
    f32x4 v[4];
#pragma unroll
    for (int j = 0; j < 4; ++j) { const u32x2 x = xp[64 * j]; v[j] = (f32x4){bf_lo(x.x), bf_hi(x.x), bf_lo(x.y), bf_hi(x.y)}; }
    float rs;
    if (m < MP) rs = row_rstd(SS, m);
    else {
        const int r = m - MP;
#pragma unroll
        for (int kz = 0; kz < 8; ++kz) { const f32x4* pp = (const f32x4*)(part + ((size_t)kz * MS + r) * DM) + lane;
#pragma unroll
            for (int j = 0; j < 4; ++j) v[j] += pp[64 * j]; }
        float sq = 0.f;
#pragma unroll
        for (int j = 0; j < 4; ++j) sq += (v[j][0] * v[j][0] + v[j][1] * v[j][1]) + (v[j][2] * v[j][2] + v[j][3] * v[j][3]);
        rs = __builtin_amdgcn_rsqf(wave_sum(sq) * (1.0f / 1024.0f) + EPS);
    }
#pragma unroll
    for (int j = 0; j < 4; ++j) p[64 * j] = v[j] * rs * gp[64 * j];
}
__device__ __forceinline__ void phase_final(unsigned char* ws, float* out, const float* fn, const int tid, const int bid, const int G) {
    const float* SS = (const float*)(ws + WS_SS) + (size_t)4 * M; const bf16_t* XB = (const bf16_t*)(ws + WS_XB); const float* part = (const float*)(ws + WS_PART);
    const int lane = tid & 63, wave = tid >> 6, gw = bid * 8 + wave, NGW = G * 8;
    for (int m0 = gw; m0 < M; m0 += 4 * NGW) {
        if (m0 + 3 * NGW < MP) {
            u32x2 x[4][4]; float ss[4];
#pragma unroll
            for (int r = 0; r < 4; ++r) { const u32x2* xp = (const u32x2*)(XB + (size_t)(m0 + r * NGW) * DM) + lane;
#pragma unroll
                for (int j = 0; j < 4; ++j) x[r][j] = xp[64 * j];
                ss[r] = SS[m0 + r * NGW]; }
            f32x4 g4[4];
#pragma unroll
            for (int j = 0; j < 4; ++j) g4[j] = ((const f32x4*)fn + lane)[64 * j];
#pragma unroll
            for (int r = 0; r < 4; ++r) { const float rs = __builtin_amdgcn_rsqf(ss[r] * (1.0f / 1024.0f) + EPS); f32x4* p = (f32x4*)(out + (size_t)(m0 + r * NGW) * DM) + lane;
#pragma unroll
                for (int j = 0; j < 4; ++j) { const f32x4 v = {bf_lo(x[r][j].x), bf_hi(x[r][j].x), bf_lo(x[r][j].y), bf_hi(x[r][j].y)}; p[64 * j] = v * rs * g4[j]; } }
        } else {
            for (int r = 0; r < 4; ++r) { const int m = m0 + r * NGW; if (m < M) final_row(SS, XB, part, out, fn, m, lane); }
        }
    }
}

#if MK_PER_PHASE
template <int KIND> __global__ void __launch_bounds__(512, 2) phase_kernel(Args a, int ph) {
    extern __shared__ __attribute__((aligned(16))) unsigned char lds_raw[];
    LAS unsigned char* lds = (LAS unsigned char*)lds_raw;
    unsigned char* ws = a.ws; float* out = a.out;
    const int G = gridDim.x, tid = threadIdx.x, bid = blockIdx.x;
    const bool noepi = ph >= 100; if (noepi) ph -= 100;
    const int l = (ph - 1) / PPL, k = (ph - 1) % PPL;
    if constexpr (KIND == 0) prologue(lds, a, tid, bid);
    else if constexpr (KIND == 3) phase_final(ws, out, a.in[I_FN], tid, bid, G);
    else if constexpr (KIND == 4) combine_sample_rows(ws, 2 * l + 2, tid, bid, G);
    else if constexpr (KIND == 2) phase_mixer(lds, ws, a.in[I_CW], a.in[I_CB], a.in[I_LG], a.in[I_LB], a.in[I_SINK], l, tid, bid, G);
    else phase_gemm(lds, ws, out, l, k, tid, bid, G, noepi);
}
#else
__global__ void __launch_bounds__(512, 2) fwd_megakernel(Args a_unused) {
    extern __shared__ __attribute__((aligned(16))) unsigned char lds_raw[];
    LAS unsigned char* lds = (LAS unsigned char*)lds_raw;
    cg::grid_group grid = cg::this_grid();
    const Args* ap0 = (const Args*)__builtin_amdgcn_kernarg_segment_ptr();
    const int ph_lo = ap0->ph_lo, ph_hi = ap0->ph_hi;
    if (threadIdx.x < 64) ((LAS unsigned*)(lds + MISC_OFF))[threadIdx.x] = 0u;
    __syncthreads();
    const int wave_id = __builtin_amdgcn_readfirstlane((int)(threadIdx.x >> 6));
    const XcdBarrier xbar = xcd_barrier_post((unsigned*)(ap0->ws + WS_CTL) + BAR_WORD0, (volatile LAS unsigned*)(lds + MISC_OFF));
#pragma unroll 1
    for (int ph = ph_lo; ph < ph_hi; ++ph) {
        const Args* ap = (const Args*)__builtin_amdgcn_kernarg_segment_ptr(); asm volatile("" : "+s"(ap));
        unsigned char* ws = opaque_uniform(ap->ws); float* out = opaque_uniform(ap->out);
        const int G = gridDim.x;
        int tid = wave_id * 64 + (int)__builtin_amdgcn_mbcnt_hi(~0u, __builtin_amdgcn_mbcnt_lo(~0u, 0u)), bid = blockIdx.x;
        asm volatile("" : "+v"(tid)); asm volatile("" : "+s"(bid)); tid &= 511; bid &= 1023;
        const int l = (ph - 1) / PPL, k = (ph - 1) % PPL;
        if (ph == N_PHASES - 2) continue;
        if (ph == 0) {
            Args a;
#pragma unroll
            for (int i = 0; i < 17; ++i) a.in[i] = ap->in[i];
            a.out = out; a.ws = ws; a.ph_lo = 0; a.ph_hi = 0;
            prologue(lds, a, tid, bid);
        } else if (ph == N_PHASES - 1) phase_final(ws, out, opaque_uniform(ap->in[I_FN]), tid, bid, G);
        else if (k == 1) phase_mixer(lds, ws, opaque_uniform(ap->in[I_CW]), opaque_uniform(ap->in[I_CB]), opaque_uniform(ap->in[I_LG]), opaque_uniform(ap->in[I_LB]), opaque_uniform(ap->in[I_SINK]), l, tid, bid, G);
        else if (k == 5) combine_sample_rows(ws, 2 * l + 2, tid, bid, G);
        else phase_gemm(lds, ws, out, l, k, tid, bid, G);
        if (ph + 1 < ph_hi) { XcdBarrier b = xbar; asm volatile("" : "+s"(b.x)); xcd_barrier(b);
            if (ph == ph_lo && xb_ld(&b.bar[XB_TMO]) != 0u) grid.sync(); }
    }
}
#endif

extern "C" void kernel_launch(void* const* d_in, const int* in_sizes, int n_in, void* d_out, int out_size, void* d_ws, size_t ws_size, hipStream_t stream) {
    static int grid = 0;
    if (grid == 0) {
        if (n_in != 17 || (size_t)out_size != O_END || ws_size < WS_END) { fprintf(stderr, "kernel_launch: unexpected shapes: n_in %d out %d ws %zu (need %zu)\n", n_in, out_size, ws_size, (size_t)WS_END); grid = -1; return; }
        int dev = 0, cus = 0, per_cu = 0;
        if (hipGetDevice(&dev) != hipSuccess || hipDeviceGetAttribute(&cus, hipDeviceAttributeMultiprocessorCount, dev) != hipSuccess) { grid = -1; return; }
#if MK_PER_PHASE
        if (hipFuncSetAttribute((const void*)phase_kernel<0>, hipFuncAttributeMaxDynamicSharedMemorySize, LDS_BYTES) != hipSuccess || hipFuncSetAttribute((const void*)phase_kernel<1>, hipFuncAttributeMaxDynamicSharedMemorySize, LDS_BYTES) != hipSuccess ||
            hipFuncSetAttribute((const void*)phase_kernel<2>, hipFuncAttributeMaxDynamicSharedMemorySize, LDS_BYTES) != hipSuccess || hipFuncSetAttribute((const void*)phase_kernel<3>, hipFuncAttributeMaxDynamicSharedMemorySize, LDS_BYTES) != hipSuccess ||
            hipFuncSetAttribute((const void*)phase_kernel<4>, hipFuncAttributeMaxDynamicSharedMemorySize, LDS_BYTES) != hipSuccess) { fprintf(stderr, "kernel_launch: hipFuncSetAttribute failed\n"); grid = -1; return; }
        (void)per_cu;
#else
        if (hipFuncSetAttribute((const void*)fwd_megakernel, hipFuncAttributeMaxDynamicSharedMemorySize, LDS_BYTES) != hipSuccess) { fprintf(stderr, "kernel_launch: hipFuncSetAttribute failed\n"); grid = -1; return; }
        if (hipOccupancyMaxActiveBlocksPerMultiprocessor(&per_cu, (const void*)fwd_megakernel, 512, LDS_BYTES) != hipSuccess || per_cu < 1) { fprintf(stderr, "kernel_launch: occupancy query says %d\n", per_cu); per_cu = 1; }
#endif
        (void)hipGetLastError();
        grid = cus;
    }
    if (grid < 0) return;
    Args a{};
    for (int i = 0; i < 17; ++i) a.in[i] = (const float*)d_in[i];
    a.out = (float*)d_out; a.ws = (unsigned char*)d_ws;
#if MK_PER_PHASE
    for (int ph0 = 0; ph0 < N_PHASES + PROBE_NREP; ++ph0) {
        const int ph = ph0 <= PROBE_REPEAT_PH ? ph0 : (ph0 <= PROBE_REPEAT_PH + PROBE_NREP ? PROBE_REPEAT_PH : ph0 - PROBE_NREP);
        const int k = (ph - 1) % PPL;
        if (ph == N_PHASES - 2) continue;
        if (ph == 0) hipLaunchKernelGGL(phase_kernel<0>, dim3(grid), dim3(512), LDS_BYTES, stream, a, ph);
        else if (ph == N_PHASES - 1) hipLaunchKernelGGL(phase_kernel<3>, dim3(grid), dim3(512), LDS_BYTES, stream, a, ph);
        else if (k == 1) hipLaunchKernelGGL(phase_kernel<2>, dim3(grid), dim3(512), LDS_BYTES, stream, a, ph);
        else if (k == 5) hipLaunchKernelGGL(phase_kernel<4>, dim3(grid), dim3(512), LDS_BYTES, stream, a, ph);
        else hipLaunchKernelGGL(phase_kernel<1>, dim3(grid), dim3(512), LDS_BYTES, stream, a, (PROBE_NOEPI && ph0 > PROBE_REPEAT_PH && ph0 <= PROBE_REPEAT_PH + PROBE_NREP) ? ph + 100 : ph);
    }
#else
    a.ph_lo = 0; a.ph_hi = N_PHASES;
    if (hipMemsetAsync((char*)d_ws + WS_CTL, 0, CTL_ZERO_BYTES, stream) != hipSuccess) { fprintf(stderr, "kernel_launch: hipMemsetAsync failed\n"); return; }
    void* kargs[] = {&a};
    const hipError_t e = hipLaunchCooperativeKernel((const void*)fwd_megakernel, dim3(grid), dim3(512), kargs, LDS_BYTES, stream);
    if (e != hipSuccess) fprintf(stderr, "kernel_launch: cooperative launch failed: %s (grid %d)\n", hipGetErrorString(e), grid);
#endif
}
```
